# Optimizing an MI355X kernel written in HIP

```python
import math
import jax
import jax.numpy as jnp
from jax import lax
import numpy as np

D_MODEL = 1024
BATCH = 16
SEQ = 2048
DEPTH = 4

F32 = jnp.float32
MEM_LEN = 256
HEAD_DIM = 64
BLOCK = 128
SWA_HEADS = 8
SWA_KV_HEADS = 2
WINDOW = 128
S5_WIDTH = 512
S5_GROUP = 16
S5_GROUPS = S5_WIDTH // S5_GROUP
S5_STATE = 64
CONV_WIDTH = 512
CONV_K = 31
DIFF_HEADS = 4
DIFF_V_DIM = 2 * HEAD_DIM
CROSS_HEADS = 4
CROSS_HEAD_DIM = 128
CROSS_WIDTH = CROSS_HEADS * CROSS_HEAD_DIM
FFN_DIM = 2816
N_BRANCHES = 4

A_Q = SWA_HEADS * HEAD_DIM
A_KV = SWA_KV_HEADS * HEAD_DIM
D_QK = DIFF_HEADS * 2 * HEAD_DIM
D_V = DIFF_HEADS * DIFF_V_DIM
CONV_IN = 2 * CONV_WIDTH
GATE_COLS = N_BRANCHES * D_MODEL
MIX_IN = A_Q + 2 * A_KV + 2 * D_QK + D_V + S5_WIDTH + CONV_IN + GATE_COLS
MIX_SPLITS = (A_Q, A_Q + A_KV, A_Q + 2 * A_KV, A_Q + 2 * A_KV + D_QK, A_Q + 2 * A_KV + 2 * D_QK, A_Q + 2 * A_KV + 2 * D_QK + D_V, A_Q + 2 * A_KV + 2 * D_QK + D_V + S5_WIDTH, A_Q + 2 * A_KV + 2 * D_QK + D_V + S5_WIDTH + CONV_IN)

DEEPNORM_ALPHA = (2.0 * DEPTH) ** 0.25
DEEPNORM_BETA = (8.0 * DEPTH) ** -0.25
LN_EPS = 1e-5
NEG_INF = -1e30

kernel_name = 'hybrid_gated_swa_s5_conv_diffattn_deepnorm'


def layer_norm(x, g, b):
    xf = x.astype(F32)
    mu = jnp.mean(xf, axis=-1, keepdims=True)
    var = jnp.mean(jnp.square(xf - mu), axis=-1, keepdims=True)
    return ((xf - mu) * lax.rsqrt(var + LN_EPS) * g.astype(F32) + b.astype(F32)).astype(x.dtype)


def alibi_slopes(n):
    return jnp.asarray([2.0 ** (-8.0 * (h + 1) / n) for h in range(n)], F32)


def swiglu_ffn(x, w_in, w_out):
    gate, up = jnp.split(x @ w_in, 2, axis=-1)
    return (jax.nn.silu(gate) * up) @ w_out


def swa_sink_attention(q, k, v, sinks):
    B, L = q.shape[0], q.shape[1]
    nb = L // BLOCK
    rep = SWA_HEADS // SWA_KV_HEADS
    qb = q.reshape(B, nb, BLOCK, SWA_KV_HEADS, rep, HEAD_DIM)

    def band(t):
        tb = t.reshape(B, nb, BLOCK, SWA_KV_HEADS, HEAD_DIM)
        tp = jnp.concatenate([jnp.zeros_like(tb[:, :1]), tb], axis=1)
        return jnp.concatenate([tp[:, :-1], tp[:, 1:]], axis=2)

    kb, vb = band(k), band(v)
    s = jnp.einsum('bnqgrd,bnkgd->bngrqk', qb.astype(F32), kb.astype(F32)) / math.sqrt(HEAD_DIM)
    blk = jnp.arange(nb)[:, None, None] * BLOCK
    qpos = blk + jnp.arange(BLOCK)[None, :, None]
    kpos = blk - BLOCK + jnp.arange(2 * BLOCK)[None, None, :]
    dist = qpos - kpos
    valid = (dist >= 0) & (dist < WINDOW) & (kpos >= 0)
    slopes = alibi_slopes(SWA_HEADS).reshape(SWA_KV_HEADS, rep)[None, None, :, :, None, None]
    s = s - slopes * dist.astype(F32)[None, :, None, None]
    s = jnp.where(valid[None, :, None, None], s, NEG_INF)
    sink = sinks.astype(F32).reshape(SWA_KV_HEADS, rep)[None, None, :, :, None, None]
    m = jnp.maximum(jnp.max(s, axis=-1, keepdims=True), sink)
    p = jnp.exp(s - m)
    p = p / (jnp.sum(p, axis=-1, keepdims=True) + jnp.exp(sink - m))
    o = jnp.einsum('bngrqk,bnkgd->bnqgrd', p.astype(v.dtype), vb)
    return o.reshape(B, L, A_Q)


def s5_ssm(u, a_re, a_im, log_step, b_re, b_im, c_re, c_im, d_skip, glu_w, glu_b):
    B, L = u.shape[0], u.shape[1]
    uf = u.astype(F32).reshape(B, L, S5_GROUPS, S5_GROUP)
    step = jnp.exp(log_step.astype(F32))[:, None]
    ar, ai = a_re.astype(F32), a_im.astype(F32)
    mag = jnp.exp(ar * step)
    abar_r, abar_i = mag * jnp.cos(ai * step), mag * jnp.sin(ai * step)
    den = ar * ar + ai * ai
    nr, ni = abar_r - 1.0, abar_i
    coef_r = (nr * ar + ni * ai) / den
    coef_i = (ni * ar - nr * ai) / den
    br, bi = b_re.astype(F32), b_im.astype(F32)
    bbar_r = coef_r[..., None] * br - coef_i[..., None] * bi
    bbar_i = coef_r[..., None] * bi + coef_i[..., None] * br
    bu_r = jnp.einsum('blgc,gpc->blgp', uf, bbar_r)
    bu_i = jnp.einsum('blgc,gpc->blgp', uf, bbar_i)
    a_r = jnp.broadcast_to(abar_r[None, None], (1, L, S5_GROUPS, S5_STATE))
    a_i = jnp.broadcast_to(abar_i[None, None], (1, L, S5_GROUPS, S5_STATE))

    def combine(e1, e2):
        a1r, a1i, b1r, b1i = e1
        a2r, a2i, b2r, b2i = e2
        return (a1r * a2r - a1i * a2i, a1r * a2i + a1i * a2r,
                a2r * b1r - a2i * b1i + b2r, a2r * b1i + a2i * b1r + b2i)

    _, _, xr, xi = lax.associative_scan(combine, (a_r, a_i, bu_r, bu_i), axis=1)
    y = jnp.einsum('gcp,blgp->blgc', c_re.astype(F32), xr) - jnp.einsum('gcp,blgp->blgc', c_im.astype(F32), xi)
    y = y.reshape(B, L, S5_WIDTH) + d_skip.astype(F32) * uf.reshape(B, L, S5_WIDTH)
    y = jax.nn.gelu(y).astype(u.dtype)
    return y * jax.nn.sigmoid(y @ glu_w + glu_b)


def conformer_conv(h, conv_w, conv_b, ln_g, ln_b):
    val, gate = jnp.split(h, 2, axis=-1)
    g = val * jax.nn.sigmoid(gate)
    y = lax.conv_general_dilated(g, conv_w[:, None, :], window_strides=(1,), padding=[(CONV_K - 1, 0)],
                                 dimension_numbers=('NWC', 'WIO', 'NWC'), feature_group_count=CONV_WIDTH)
    y = layer_norm(y + conv_b, ln_g, ln_b)
    return jax.nn.silu(y)


def diff_attention(q, k, v, lam, norm_g, lambda_init):
    B, L = q.shape[0], q.shape[1]
    nb = L // BLOCK
    kf = k.astype(F32).reshape(B, L, DIFF_HEADS, 2, HEAD_DIM)
    vh = v.reshape(B, L, DIFF_HEADS, DIFF_V_DIM)
    qblocks = jnp.moveaxis(q.reshape(B, nb, BLOCK, DIFF_HEADS, 2, HEAD_DIM), 1, 0)
    slopes = alibi_slopes(DIFF_HEADS)[None, :, None, None, None]
    kpos = jnp.arange(L)

    def one_block(args):
        qb, n = args
        s = jnp.einsum('bqhcd,bkhcd->bhcqk', qb.astype(F32), kf) / math.sqrt(HEAD_DIM)
        qpos = n * BLOCK + jnp.arange(BLOCK)
        dist = qpos[:, None] - kpos[None, :]
        s = jnp.where(dist >= 0, s - slopes * dist.astype(F32), NEG_INF)
        p = jax.nn.softmax(s, axis=-1)
        w = p[:, :, 0] - lam * p[:, :, 1]
        return jnp.einsum('bhqk,bkhe->bqhe', w.astype(v.dtype), vh)

    o = lax.map(one_block, (qblocks, jnp.arange(nb)))
    o = jnp.moveaxis(o, 0, 1).reshape(B, L, DIFF_HEADS, DIFF_V_DIM).astype(F32)
    o = o * lax.rsqrt(jnp.mean(o * o, axis=-1, keepdims=True) + LN_EPS) * norm_g.astype(F32) * (1.0 - lambda_init)
    return o.astype(v.dtype).reshape(B, L, D_V)


def hybrid_mixer(x, w_in, swa_sinks, swa_proj, s5_a_re, s5_a_im, s5_log_step, s5_b_re, s5_b_im, s5_c_re, s5_c_im,
                 s5_d, s5_glu_w, s5_glu_b, s5_proj, conv_w, conv_b, conv_ln_g, conv_ln_b, conv_proj,
                 diff_lq1, diff_lk1, diff_lq2, diff_lk2, diff_norm_g, diff_proj, w_out, lambda_init):
    B, L = x.shape[0], x.shape[1]
    h = x @ w_in
    aq, ak, av, dq, dk, dv, su, cu, gl = jnp.split(h, MIX_SPLITS, axis=-1)
    gates = jax.nn.sigmoid(gl).reshape(B, L, N_BRANCHES, D_MODEL)
    y_a = swa_sink_attention(aq, ak, av, swa_sinks) @ swa_proj
    y_b = s5_ssm(su, s5_a_re, s5_a_im, s5_log_step, s5_b_re, s5_b_im, s5_c_re, s5_c_im, s5_d, s5_glu_w, s5_glu_b) @ s5_proj
    y_c = conformer_conv(cu, conv_w, conv_b, conv_ln_g, conv_ln_b) @ conv_proj
    lam = (jnp.exp(jnp.sum(diff_lq1.astype(F32) * diff_lk1.astype(F32)))
           - jnp.exp(jnp.sum(diff_lq2.astype(F32) * diff_lk2.astype(F32))) + lambda_init)
    y_d = diff_attention(dq, dk, dv, lam, diff_norm_g, lambda_init) @ diff_proj
    merged = gates[:, :, 0] * y_a + gates[:, :, 1] * y_b + gates[:, :, 2] * y_c + gates[:, :, 3] * y_d
    return merged @ w_out


def cross_attention(x, mem_n, wq, wkv, wo):
    B, L = x.shape[0], x.shape[1]
    M = mem_n.shape[1]
    q = (x @ wq).reshape(B, L, CROSS_HEADS, CROSS_HEAD_DIM)
    k, v = jnp.split(mem_n @ wkv, 2, axis=-1)
    k = k.reshape(B, M, CROSS_HEADS, CROSS_HEAD_DIM)
    v = v.reshape(B, M, CROSS_HEADS, CROSS_HEAD_DIM)
    s = jnp.einsum('bqhe,bmhe->bhqm', q.astype(F32), k.astype(F32)) / math.sqrt(CROSS_HEAD_DIM)
    p = jax.nn.softmax(s, axis=-1)
    o = jnp.einsum('bhqm,bmhe->bqhe', p.astype(v.dtype), v).reshape(B, L, CROSS_WIDTH)
    return o @ wo


def setup_inputs(seed: int = 0) -> dict:
    key = jax.random.key(seed)
    keys = jax.random.split(key, 64)
    counter = [0]

    def nk():
        counter[0] += 1
        return keys[counter[0] - 1]

    def nrm(shape, scale):
        return scale * jax.random.normal(nk(), shape, F32)

    def gain(shape):
        return 1.0 + nrm(shape, 0.02)

    Ld, D, F = DEPTH, D_MODEL, FFN_DIM
    G, P, C = S5_GROUPS, S5_STATE, S5_GROUP
    inputs = {}
    inputs['x'] = nrm((BATCH, SEQ, D), 1.0)
    inputs['mem'] = nrm((BATCH, MEM_LEN, D), 1.0)
    inputs['ffn1_w_in'] = nrm((Ld, D, 2 * F), D ** -0.5)
    inputs['ffn1_w_out'] = nrm((Ld, F, D), DEEPNORM_BETA * F ** -0.5)
    inputs['ffn1_ln_g'] = gain((Ld, D))
    inputs['ffn1_ln_b'] = nrm((Ld, D), 0.02)
    inputs['mix_w_in'] = nrm((Ld, D, MIX_IN), D ** -0.5)
    inputs['swa_sinks'] = nrm((Ld, SWA_HEADS), 1.0)
    inputs['swa_proj'] = nrm((Ld, A_Q, D), A_Q ** -0.5)
    inputs['s5_a_re'] = -0.5 + nrm((Ld, G, P), 0.01)
    inputs['s5_a_im'] = math.pi * jnp.arange(P, dtype=F32) + nrm((Ld, G, P), 0.01)
    inputs['s5_log_step'] = jax.random.uniform(nk(), (Ld, G), F32, math.log(1e-3), math.log(1e-1))
    inputs['s5_b_re'] = nrm((Ld, G, P, C), (2.0 * C) ** -0.5)
    inputs['s5_b_im'] = nrm((Ld, G, P, C), (2.0 * C) ** -0.5)
    inputs['s5_c_re'] = nrm((Ld, G, C, P), (2.0 * P) ** -0.5)
    inputs['s5_c_im'] = nrm((Ld, G, C, P), (2.0 * P) ** -0.5)
    inputs['s5_d'] = nrm((Ld, S5_WIDTH), 1.0)
    inputs['s5_glu_w'] = nrm((Ld, S5_WIDTH, S5_WIDTH), S5_WIDTH ** -0.5)
    inputs['s5_glu_b'] = nrm((Ld, S5_WIDTH), 0.02)
    inputs['s5_proj'] = nrm((Ld, S5_WIDTH, D), S5_WIDTH ** -0.5)
    inputs['conv_w'] = nrm((Ld, CONV_K, CONV_WIDTH), CONV_K ** -0.5)
    inputs['conv_b'] = nrm((Ld, CONV_WIDTH), 0.02)
    inputs['conv_ln_g'] = gain((Ld, CONV_WIDTH))
    inputs['conv_ln_b'] = nrm((Ld, CONV_WIDTH), 0.02)
    inputs['conv_proj'] = nrm((Ld, CONV_WIDTH, D), CONV_WIDTH ** -0.5)
    inputs['diff_lq1'] = nrm((Ld, HEAD_DIM), 0.1)
    inputs['diff_lk1'] = nrm((Ld, HEAD_DIM), 0.1)
    inputs['diff_lq2'] = nrm((Ld, HEAD_DIM), 0.1)
    inputs['diff_lk2'] = nrm((Ld, HEAD_DIM), 0.1)
    inputs['diff_norm_g'] = gain((Ld, DIFF_V_DIM))
    inputs['diff_proj'] = nrm((Ld, D_V, D), D_V ** -0.5)
    inputs['mix_w_out'] = nrm((Ld, D, D), DEEPNORM_BETA * D ** -0.5)
    inputs['mix_ln_g'] = gain((Ld, D))
    inputs['mix_ln_b'] = nrm((Ld, D), 0.02)
    inputs['mem_ln_g'] = gain((D,))
    inputs['mem_ln_b'] = nrm((D,), 0.02)
    inputs['cross_wq'] = nrm((Ld, D, CROSS_WIDTH), D ** -0.5)
    inputs['cross_wkv'] = nrm((Ld, D, 2 * CROSS_WIDTH), D ** -0.5)
    inputs['cross_wo'] = nrm((Ld, CROSS_WIDTH, D), DEEPNORM_BETA * CROSS_WIDTH ** -0.5)
    inputs['cross_ln_g'] = gain((Ld, D))
    inputs['cross_ln_b'] = nrm((Ld, D), 0.02)
    inputs['ffn2_w_in'] = nrm((Ld, D, 2 * F), D ** -0.5)
    inputs['ffn2_w_out'] = nrm((Ld, F, D), DEEPNORM_BETA * F ** -0.5)
    inputs['ffn2_ln_g'] = gain((Ld, D))
    inputs['ffn2_ln_b'] = nrm((Ld, D), 0.02)
    return inputs


def reference(x, mem, ffn1_w_in, ffn1_w_out, ffn1_ln_g, ffn1_ln_b, mix_w_in, swa_sinks, swa_proj,
              s5_a_re, s5_a_im, s5_log_step, s5_b_re, s5_b_im, s5_c_re, s5_c_im, s5_d, s5_glu_w, s5_glu_b, s5_proj,
              conv_w, conv_b, conv_ln_g, conv_ln_b, conv_proj,
              diff_lq1, diff_lk1, diff_lq2, diff_lk2, diff_norm_g, diff_proj,
              mix_w_out, mix_ln_g, mix_ln_b, mem_ln_g, mem_ln_b,
              cross_wq, cross_wkv, cross_wo, cross_ln_g, cross_ln_b,
              ffn2_w_in, ffn2_w_out, ffn2_ln_g, ffn2_ln_b):
    mem_n = layer_norm(mem, mem_ln_g, mem_ln_b)
    for l in range(DEPTH):
        f = swiglu_ffn(x, ffn1_w_in[l], ffn1_w_out[l])
        x = layer_norm(DEEPNORM_ALPHA * x + 0.5 * f, ffn1_ln_g[l], ffn1_ln_b[l])
        lambda_init = 0.8 - 0.6 * math.exp(-0.3 * l)
        m = hybrid_mixer(x, mix_w_in[l], swa_sinks[l], swa_proj[l], s5_a_re[l], s5_a_im[l], s5_log_step[l],
                         s5_b_re[l], s5_b_im[l], s5_c_re[l], s5_c_im[l], s5_d[l], s5_glu_w[l], s5_glu_b[l], s5_proj[l],
                         conv_w[l], conv_b[l], conv_ln_g[l], conv_ln_b[l], conv_proj[l],
                         diff_lq1[l], diff_lk1[l], diff_lq2[l], diff_lk2[l], diff_norm_g[l], diff_proj[l],
                         mix_w_out[l], lambda_init)
        x = layer_norm(DEEPNORM_ALPHA * x + m, mix_ln_g[l], mix_ln_b[l])
        c = cross_attention(x, mem_n, cross_wq[l], cross_wkv[l], cross_wo[l])
        x = layer_norm(DEEPNORM_ALPHA * x + c, cross_ln_g[l], cross_ln_b[l])
        f = swiglu_ffn(x, ffn2_w_in[l], ffn2_w_out[l])
        x = layer_norm(DEEPNORM_ALPHA * x + 0.5 * f, ffn2_ln_g[l], ffn2_ln_b[l])
    return x
```

```cpp
#include <hip/hip_runtime.h>
#include <hip/hip_cooperative_groups.h>
#include <cstdio>
#include <cstring>
namespace cg = cooperative_groups;

typedef _Float16 hf;
typedef _Float16 h8 __attribute__((ext_vector_type(8)));
typedef _Float16 h4 __attribute__((ext_vector_type(4)));
typedef short s4v __attribute__((ext_vector_type(4)));
typedef float f4 __attribute__((ext_vector_type(4)));

constexpr int NTOK = 32768, SEQ = 2048, FFN = 2816;
constexpr int LDS_BYTES = 140 * 1024;
constexpr int CTL_OFF = 136 * 1024;
constexpr float LOG2E = 1.4426950408889634f;
constexpr float DN_ALPHA = 1.681792830507429f;

struct Params {
  const float* in[45];
  float* out;
  hf *x16, *w1in, *w1out, *wmix, *pswa, *ps5, *pconv, *pdiff, *glu, *wout, *wq, *wo, *wkv, *kvc, *memn;
  hf *aq, *akv, *dq, *dk, *dv, *su, *cu, *s5tmp, *convout, *swo, *dfo;
  unsigned* counters;
  unsigned pad_;
  unsigned pad2_;
};

extern __shared__ __attribute__((aligned(16))) unsigned char smem[];
__device__ __forceinline__ int tidx() { int t = __builtin_amdgcn_workitem_id_x(); asm volatile("" : "+v"(t)); return t; }
typedef const __attribute__((address_space(4))) Params* KP;
__device__ __forceinline__ KP getp() {
  volatile __attribute__((address_space(3))) unsigned* s = (volatile __attribute__((address_space(3))) unsigned*)(smem + 136 * 1024 + 16);
  const unsigned lo = __builtin_amdgcn_readfirstlane(s[0]), hi = __builtin_amdgcn_readfirstlane(s[1]);
  unsigned long long v = ((unsigned long long)hi << 32) | lo;
  asm volatile("" : "+s"(v));
  return (KP)v;
}

#define XB_TMO      128
#define XB_XCNT(j)  (256  + 64 * (j))
#define XB_XSUB(j)  (1280 + 64 * (j))
#define XB_XGEN(j)  (2304 + 64 * (j))
#define XB_TOP      3328
#define XB_TOPGEN   3392
#define XB_SPIN_CAP (1u << 20)
__device__ __forceinline__ unsigned xb_ld(unsigned* p)              { return __hip_atomic_load(p, __ATOMIC_RELAXED, __HIP_MEMORY_SCOPE_AGENT); }
__device__ __forceinline__ unsigned xb_add(unsigned* p, unsigned v) { return __hip_atomic_fetch_add(p, v, __ATOMIC_RELAXED, __HIP_MEMORY_SCOPE_AGENT); }
__device__ __forceinline__ unsigned xb_xcc_id() { return (unsigned)__builtin_amdgcn_s_getreg((3 << 11) | 20) & 0xFu; }
#define XB_SPIN(cond, bar) do { unsigned _sp = 0; while (cond) { __builtin_amdgcn_s_sleep(1); \
    if ((++_sp & 255u) == 0u) { if (xb_ld(&(bar)[XB_TMO])) break; if (_sp > XB_SPIN_CAP) { atomicAdd(&(bar)[XB_TMO], 1u); break; } } } } while (0)
__device__ __forceinline__ void xcd_barrier_complete(unsigned* bar, unsigned x, unsigned& nloc, unsigned& nx) {
  const unsigned G = gridDim.x;
  unsigned sum, cnt, mine, sp = 0u;
  for (;;) {
    sum = 0u; cnt = 0u; mine = 0u;
#pragma unroll
    for (unsigned j = 0; j < 16; ++j) { const unsigned c = xb_ld(&bar[XB_XCNT(j)]); sum += c; cnt += (c > 0u) ? 1u : 0u; mine = (j == x) ? c : mine; }
    if (sum == G) break;
    __builtin_amdgcn_s_sleep(1);
    if ((++sp & 255u) == 0u) { if (xb_ld(&bar[XB_TMO])) break; if (sp > XB_SPIN_CAP) { atomicAdd(&bar[XB_TMO], 1u); break; } }
  }
  nloc = mine > 0u ? mine : 1u; nx = cnt > 0u ? cnt : 1u;
}
__device__ __forceinline__ void gbar() {
  asm volatile("s_waitcnt vmcnt(0)" ::: "memory");
  __syncthreads();
  if (tidx() == 0) {
    unsigned* bar = getp()->counters;
    volatile __attribute__((address_space(3))) unsigned* st = (volatile __attribute__((address_space(3))) unsigned*)(smem + 136 * 1024 + 32);
    const unsigned x = xb_xcc_id();
    __builtin_amdgcn_s_waitcnt(0);
    unsigned nloc = st[0], nx = st[1];
    if (nloc == 0u) { xcd_barrier_complete(bar, x, nloc, nx); st[0] = nloc; st[1] = nx; }
    const unsigned old = xb_add(&bar[XB_XSUB(x)], 1u);
    const unsigned gen = old / nloc;
    if (old + 1u == (gen + 1u) * nloc) {
      __builtin_amdgcn_fence(__ATOMIC_RELEASE, "agent");
      asm volatile("s_waitcnt vmcnt(0)" ::: "memory");
      const unsigned og = xb_add(&bar[XB_TOP], 1u);
      const unsigned tg = og / nx;
      if (og + 1u == (tg + 1u) * nx) xb_add(&bar[XB_TOPGEN], 1u);
      else XB_SPIN(xb_ld(&bar[XB_TOPGEN]) == tg, bar);
      __builtin_amdgcn_fence(__ATOMIC_ACQUIRE, "agent");
      xb_add(&bar[XB_XGEN(x)], 1u);
      asm volatile("s_waitcnt vmcnt(0)" ::: "memory");
    } else {
      XB_SPIN(xb_ld(&bar[XB_XGEN(x)]) == gen, bar);
      __builtin_amdgcn_fence(__ATOMIC_ACQUIRE, "agent");
      asm volatile("s_waitcnt vmcnt(0)" ::: "memory");
    }
  }
  __syncthreads();
}

constexpr int BM = 256, BK = 64, HALFT = 128, HT = HALFT * BK;
__device__ __forceinline__ int lds_byte(int r, int c) {
  int st = (r >> 4) * 2 + (c >> 5), rr = r & 15, cc = c & 31, ob = rr * 64 + cc * 2;
  return st * 1024 + (ob ^ (((ob >> 9) & 1) << 5));
}
__device__ __forceinline__ void stage_rc(int b, int& R, int& C) {
  int st = b / 1024, sb = b % 1024, swz = sb ^ (((sb >> 9) & 1) << 5);
  R = (st >> 1) * 16 + swz / 64; C = (st & 1) * 32 + (swz % 64) / 2;
}
__device__ __forceinline__ bool tile_order(int i, int nM, int nN, int& pm, int& pn) {
  const int nwg = nM * nN; const int L = i * (int)gridDim.x + (int)blockIdx.x; if (L >= nwg) return false;
  int wgid = (int)L; { const int q = nwg / 8, r = nwg % 8, xcd = wgid % 8, off = wgid / 8; wgid = (xcd < r ? xcd * (q + 1) : r * (q + 1) + (xcd - r) * q) + off; }
  const int nig = 8 * nN, gid = wgid / nig, fm = gid * 8, gsz = (nM - fm) < 8 ? (nM - fm) : 8;
  pm = fm + ((wgid % nig) % gsz); pn = (wgid % nig) / gsz; return true;
}

#define LAS __attribute__((address_space(3)))
constexpr int HTB = HALFT * BK * 2;
struct GU { const char* A; const char* B; int lda, ldb, nt, brow, bcol, aux; };

template <class Prov, class Epi>
__device__ __forceinline__ void gemm_stream(Prov prov, Epi epi) {
  LAS unsigned char* lds = (LAS unsigned char*)smem;
  const int tid = tidx();
  const int wid = __builtin_amdgcn_readfirstlane(tid >> 6), lane = tid & 63, wr = wid >> 2, wc = wid & 3, fr = lane & 15, fq = lane >> 4;
  int sR[2], sC[2];
#pragma unroll
  for (int i = 0; i < 2; ++i) stage_rc(tid * 16 + i * 8192, sR[i], sC[i]);
  const size_t kstep = (size_t)(BK * 2);
  const unsigned ldsw = (unsigned)wid * 1024u;
  const int aoff = lds_byte(wr * 64 + fr, fq * 8), boff = lds_byte(wc * 32 + fr, fq * 8);
  GU cur, nxt;
  if (!prov(0, cur)) return;
  int ui = 0;
#define GSA(b, h) (((b)*2 + (h)) * HTB)
#define GSB(b, h) ((4 + (b)*2 + (h)) * HTB)
#define STAGE(bufoff, gbase, ld) do { _Pragma("unroll") for (int _i = 0; _i < 2; ++_i) \
    __builtin_amdgcn_global_load_lds((const unsigned*)((const char*)(gbase) + (unsigned)((sR[_i] * (ld) + sC[_i]) * 2)), (LAS unsigned*)(lds + (bufoff) + ldsw + _i * 8192), 16, 0, 0); } while (0)
#define LDA(dst, b, h) do { _Pragma("unroll") for (int m = 0; m < 4; ++m) _Pragma("unroll") for (int k = 0; k < 2; ++k) dst[m][k] = *(const LAS h8*)(lds + GSA(b, h) + aoff + m * 2048 + k * 1024); } while (0)
#define LDB(dst, b, h) do { _Pragma("unroll") for (int n = 0; n < 2; ++n) _Pragma("unroll") for (int k = 0; k < 2; ++k) dst[n][k] = *(const LAS h8*)(lds + GSB(b, h) + boff + n * 2048 + k * 1024); } while (0)
#define MMA(ai, bj, At_, Bt_) do { __builtin_amdgcn_s_setprio(1); _Pragma("unroll") for (int m = 0; m < 4; ++m) _Pragma("unroll") for (int n = 0; n < 2; ++n) _Pragma("unroll") for (int k = 0; k < 2; ++k) \
      acc[ai][bj][m][n] = __builtin_amdgcn_mfma_f32_16x16x32_f16(Bt_[n][k], At_[m][k], acc[ai][bj][m][n], 0, 0, 0); \
    __builtin_amdgcn_s_setprio(0); } while (0)
#define WAIT_V(n) asm volatile("s_waitcnt vmcnt(" #n ")" ::: "memory")
#define WAIT_L(n) asm volatile("s_waitcnt lgkmcnt(" #n ")" ::: "memory")
#define BAR __builtin_amdgcn_s_barrier()
#define SCHED __builtin_amdgcn_sched_barrier(0)
#define ZERO_ACC _Pragma("unroll") for (int a = 0; a < 2; ++a) _Pragma("unroll") for (int b = 0; b < 2; ++b) _Pragma("unroll") for (int m = 0; m < 4; ++m) _Pragma("unroll") for (int n = 0; n < 2; ++n) acc[a][b][m][n] = (f4){0.f, 0.f, 0.f, 0.f}
  f4 acc[2][2][4][2];
  ZERO_ACC;
  h8 At[4][2], B0[2][2], B1[2][2];
  { const size_t hA = (size_t)HALFT * cur.lda * 2, hB = (size_t)HALFT * cur.ldb * 2;
    STAGE(GSB(0, 0), cur.B, cur.ldb); STAGE(GSB(0, 1), cur.B + hB, cur.ldb); STAGE(GSA(0, 0), cur.A, cur.lda); STAGE(GSA(0, 1), cur.A + hA, cur.lda);
    if (wr == 1) BAR;
    WAIT_V(2); BAR;
    STAGE(GSB(1, 0), cur.B + kstep, cur.ldb); STAGE(GSA(1, 0), cur.A + kstep, cur.lda); STAGE(GSB(1, 1), cur.B + hB + kstep, cur.ldb);
    WAIT_V(6); BAR; }
#pragma unroll 1
  for (;;) {
    const bool has_next = prov(ui + 1, nxt);
    if (!has_next) nxt = cur;
    const int nt = cur.nt;
    const size_t hA = (size_t)HALFT * cur.lda * 2;
#pragma unroll 1
    for (int t = 0; t < nt; t += 2) {
      const bool last = (t + 2 >= nt);
      const char* a1 = cur.A + (size_t)(t + 1) * kstep + hA;
      const char* a2 = last ? nxt.A : cur.A + (size_t)(t + 2) * kstep;
      const char* b2 = last ? nxt.B : cur.B + (size_t)(t + 2) * kstep;
      const int lda2 = last ? nxt.lda : cur.lda, ldb2 = last ? nxt.ldb : cur.ldb;
      const size_t hA2 = (size_t)HALFT * lda2 * 2, hB2 = (size_t)HALFT * ldb2 * 2;
      LDB(B0, 0, 0); LDB(B1, 0, 1); SCHED; LDA(At, 0, 0); STAGE(GSA(1, 1), a1, cur.lda);
      WAIT_V(8); WAIT_L(0); BAR; MMA(0, 0, At, B0); MMA(0, 1, At, B1); BAR; SCHED;
      LDA(At, 0, 1); STAGE(GSB(0, 0), b2, ldb2); STAGE(GSB(0, 1), b2 + hB2, ldb2); STAGE(GSA(0, 0), a2, lda2);
      WAIT_V(8); WAIT_L(0); BAR; MMA(1, 0, At, B0); MMA(1, 1, At, B1); BAR; SCHED;
      LDB(B0, 1, 0); LDB(B1, 1, 1); SCHED; LDA(At, 1, 0); STAGE(GSA(0, 1), a2 + hA2, lda2);
      WAIT_V(8); WAIT_L(0); BAR; MMA(0, 0, At, B0); MMA(0, 1, At, B1); BAR; SCHED;
      LDA(At, 1, 1); STAGE(GSB(1, 0), b2 + kstep, ldb2); STAGE(GSB(1, 1), b2 + hB2 + kstep, ldb2); STAGE(GSA(1, 0), a2 + kstep, lda2);
      WAIT_V(8); WAIT_L(0); BAR; MMA(1, 0, At, B0); MMA(1, 1, At, B1); BAR; SCHED;
    }
    if (wr == 0) BAR;
    epi(acc, cur, wr, wc, fr, fq);
    ZERO_ACC;
    if (!has_next) break;
    cur = nxt; ++ui;
    if (wr == 1) BAR;
  }
  __syncthreads();
#undef GSA
#undef GSB
#undef STAGE
#undef LDA
#undef LDB
#undef MMA
#undef ZERO_ACC
}

#define EPI_ARGS const f4 (&acc)[2][2][4][2], const GU& d, int wr, int wc, int fr, int fq
#define EPI_ROWS _Pragma("unroll") for (int ai = 0; ai < 2; ++ai) _Pragma("unroll") for (int m = 0; m < 4; ++m)
#define EPI_COLS _Pragma("unroll") for (int bj = 0; bj < 2; ++bj) _Pragma("unroll") for (int n = 0; n < 2; ++n)
#define AINL __attribute__((always_inline))

__device__ __forceinline__ float sigmoidf_(float x) { return __builtin_amdgcn_rcpf(1.0f + __builtin_amdgcn_exp2f(-1.4426950408889634f * x)); }
__device__ __forceinline__ h4 cvt4(f4 v) { h4 r; r[0] = (hf)v[0]; r[1] = (hf)v[1]; r[2] = (hf)v[2]; r[3] = (hf)v[3]; return r; }
__device__ __forceinline__ h8 cvt8(f4 a, f4 b) { h8 r; r[0] = (hf)a[0]; r[1] = (hf)a[1]; r[2] = (hf)a[2]; r[3] = (hf)a[3]; r[4] = (hf)b[0]; r[5] = (hf)b[1]; r[6] = (hf)b[2]; r[7] = (hf)b[3]; return r; }
#define EPI_BJ _Pragma("unroll") for (int bj = 0; bj < 2; ++bj)
__device__ __forceinline__ void set_gu(GU& d, const hf* A, int lda, const hf* B, int ldb, int K, int brow, int bcol, int aux) {
  d.A = (const char*)(A + (size_t)brow * lda); d.B = (const char*)(B + (size_t)bcol * ldb); d.lda = lda; d.ldb = ldb; d.nt = K / BK; d.brow = brow; d.bcol = bcol; d.aux = aux;
}

__device__ __forceinline__ void phase_ffn_a(KP p, const hf* w_in, bool with_kv) {
  hf* hidden = p->aq; hf* kvc = p->kvc;
  const hf* x16 = p->x16; const hf* memn = p->memn; const hf* wkv = p->wkv;
  const int nA = 128 * 22, total = nA + (with_kv ? 256 : 0);
  gemm_stream([&](int i, GU& d) AINL -> bool {
      const int L = i * (int)gridDim.x + (int)blockIdx.x; if (L >= total) return false;
      if (L < nA) {
        int wgid = (int)L; const int q = nA / 8, off = wgid / 8, xcd = wgid % 8; wgid = xcd * q + off;
        const int nig = 8 * 22, gid = wgid / nig, fm = gid * 8, pm = fm + ((wgid % nig) % 8), pn = (wgid % nig) / 8;
        set_gu(d, x16, 1024, w_in, 1024, 1024, pm * 256, pn * 256, 0);
      } else {
        const int t = (int)L - nA, l = t >> 6, pm = (t & 63) >> 2, pn = t & 3;
        set_gu(d, memn, 1024, wkv + (size_t)l * 1024 * 1024, 1024, 1024, pm * 256, pn * 256, 1 + l);
      }
      return true; },
    [&](EPI_ARGS) AINL {
      if (d.aux == 0) {
        EPI_ROWS { const long row = d.brow + ai * 128 + wr * 64 + m * 16 + fr;
          f4 v[2];
          _Pragma("unroll") for (int n = 0; n < 2; ++n) { const f4 g = acc[ai][0][m][n], u = acc[ai][1][m][n];
            _Pragma("unroll") for (int j = 0; j < 4; ++j) v[n][j] = g[j] * sigmoidf_(g[j]) * u[j]; }
          *(h8*)(hidden + row * FFN + (d.bcol >> 1) + wc * 32 + fq * 8) = cvt8(v[0], v[1]); }
      } else {
        hf* dst = kvc + (size_t)(d.aux - 1) * 4096 * 1024;
        EPI_ROWS { const long row = d.brow + ai * 128 + wr * 64 + m * 16 + fr;
          EPI_BJ { *(h8*)(dst + row * 1024 + d.bcol + bj * 128 + wc * 32 + fq * 8) = cvt8(acc[ai][bj][m][0], acc[ai][bj][m][1]); } }
      } });
}

__device__ __forceinline__ void phase_resid(KP p, const hf* A, int lda, const hf* Wt, int K, float scale) {
  float* out = p->out; const hf* res = p->x16;
  gemm_stream([&](int i, GU& d) AINL -> bool { int pm, pn; if (!tile_order(i, 128, 4, pm, pn)) return false; set_gu(d, A, lda, Wt, K, K, pm * 256, pn * 256, 0); return true; },
    [&](EPI_ARGS) AINL {
      EPI_ROWS { const long row = d.brow + ai * 128 + wr * 64 + m * 16 + fr;
        EPI_BJ { const long o = row * 1024 + d.bcol + bj * 128 + wc * 32 + fq * 8;
          const h8 r = *(const h8*)(res + o); f4 v0 = acc[ai][bj][m][0], v1 = acc[ai][bj][m][1];
          _Pragma("unroll") for (int j = 0; j < 4; ++j) { v0[j] = DN_ALPHA * (float)r[j] + scale * v0[j]; v1[j] = DN_ALPHA * (float)r[4 + j] + scale * v1[j]; }
          *(f4*)(out + o) = v0; *(f4*)(out + o + 4) = v1; } } });
}

__device__ __forceinline__ void phase_mix_a(KP p) {
  gemm_stream([&](int i, GU& d) AINL -> bool { int pm, pn; if (!tile_order(i, 128, 15, pm, pn)) return false; KP q = getp(); set_gu(d, q->x16, 1024, q->wmix, 1024, 1024, pm * 256, pn * 256, pn); return true; },
    [&](EPI_ARGS) AINL {
      const int pn = d.aux; hf* dst; int ldc, coff; KP q = getp();
      if (pn < 2) { dst = q->aq; ldc = 512; coff = pn * 256; }
      else if (pn == 2) { dst = q->akv; ldc = 256; coff = 0; }
      else if (pn < 5) { dst = q->dq; ldc = 512; coff = (pn - 3) * 256; }
      else if (pn < 7) { dst = q->dk; ldc = 512; coff = (pn - 5) * 256; }
      else if (pn < 9) { dst = q->dv; ldc = 512; coff = (pn - 7) * 256; }
      else if (pn < 11) { dst = q->su; ldc = 512; coff = (pn - 9) * 256; }
      else { dst = q->cu; ldc = 1024; coff = (pn - 11) * 256; }
      EPI_ROWS { const long row = d.brow + ai * 128 + wr * 64 + m * 16 + fr;
        EPI_BJ { *(h8*)(dst + row * ldc + coff + bj * 128 + wc * 32 + fq * 8) = cvt8(acc[ai][bj][m][0], acc[ai][bj][m][1]); } } });
}

__device__ __forceinline__ void phase_plain(const hf* A, int lda, const hf* Wt, int K, hf* dst, int ldc, int nM, int nN) {
  gemm_stream([&](int i, GU& d) AINL -> bool { int pm, pn; if (!tile_order(i, nM, nN, pm, pn)) return false; set_gu(d, A, lda, Wt, K, K, pm * 256, pn * 256, 0); return true; },
    [&](EPI_ARGS) AINL {
      EPI_ROWS { const long row = d.brow + ai * 128 + wr * 64 + m * 16 + fr;
        EPI_BJ { *(h8*)(dst + row * ldc + d.bcol + bj * 128 + wc * 32 + fq * 8) = cvt8(acc[ai][bj][m][0], acc[ai][bj][m][1]); } } });
}

__device__ __forceinline__ void phase_s5_glu(KP p, int l) {
  const float* gb = p->in[18] + l * 512; const hf* y = p->s5tmp; hf* dst = p->su; const hf* glu = p->glu;
  gemm_stream([&](int i, GU& d) AINL -> bool { int pm, pn; if (!tile_order(i, 128, 2, pm, pn)) return false; set_gu(d, y, 512, glu, 512, 512, pm * 256, pn * 256, 0); return true; },
    [&](EPI_ARGS) AINL {
      EPI_ROWS { const long row = d.brow + ai * 128 + wr * 64 + m * 16 + fr;
        EPI_BJ { const int col = d.bcol + bj * 128 + wc * 32 + fq * 8;
          const h8 yy = *(const h8*)(y + row * 512 + col); const f4 b0 = *(const f4*)(gb + col), b1 = *(const f4*)(gb + col + 4); f4 v0 = acc[ai][bj][m][0], v1 = acc[ai][bj][m][1];
          _Pragma("unroll") for (int j = 0; j < 4; ++j) { v0[j] = (float)yy[j] * sigmoidf_(v0[j] + b0[j]); v1[j] = (float)yy[4 + j] * sigmoidf_(v1[j] + b1[j]); }
          *(h8*)(dst + row * 512 + col) = cvt8(v0, v1); } } });
}

__device__ __forceinline__ void phase_merge(KP p) {
  gemm_stream([&](int idx, GU& d) AINL -> bool {
      const int it = idx >> 3, s = idx & 7, i = s >> 1; int pm, pn; if (!tile_order(it, 128, 4, pm, pn)) return false;
      KP q = getp();
      if ((s & 1) == 0) set_gu(d, q->x16, 1024, q->wmix + (size_t)(3840 + i * 1024) * 1024, 1024, 1024, pm * 256, pn * 256, s);
      else { const hf* A = i == 0 ? q->swo : i == 1 ? q->su : i == 2 ? q->convout : q->dfo; const hf* W = i == 0 ? q->pswa : i == 1 ? q->ps5 : i == 2 ? q->pconv : q->pdiff;
        set_gu(d, A, 512, W, 512, 512, pm * 256, pn * 256, s); }
      return true; },
    [&](EPI_ARGS) AINL {
      const int s = d.aux; KP q = getp(); hf* gbuf = q->dk; hf* merged = q->cu;
      if ((s & 1) == 0) {
        EPI_ROWS { const long row = d.brow + ai * 128 + wr * 64 + m * 16 + fr;
          EPI_BJ { f4 v0 = acc[ai][bj][m][0], v1 = acc[ai][bj][m][1]; _Pragma("unroll") for (int j = 0; j < 4; ++j) { v0[j] = sigmoidf_(v0[j]); v1[j] = sigmoidf_(v1[j]); }
            *(h8*)(gbuf + row * 1024 + d.bcol + bj * 128 + wc * 32 + fq * 8) = cvt8(v0, v1); } }
      } else {
        EPI_ROWS { const long row = d.brow + ai * 128 + wr * 64 + m * 16 + fr;
          EPI_BJ { const long o = row * 1024 + d.bcol + bj * 128 + wc * 32 + fq * 8;
            const h8 g = *(const h8*)(gbuf + o); f4 v0 = acc[ai][bj][m][0], v1 = acc[ai][bj][m][1];
            _Pragma("unroll") for (int j = 0; j < 4; ++j) { v0[j] *= (float)g[j]; v1[j] *= (float)g[4 + j]; }
            if (s > 1) { const h8 mo = *(const h8*)(merged + o); _Pragma("unroll") for (int j = 0; j < 4; ++j) { v0[j] += (float)mo[j]; v1[j] += (float)mo[4 + j]; } }
            *(h8*)(merged + o) = cvt8(v0, v1); } }
      } });
}

__device__ __forceinline__ float wave_sum(float v) {
  for (int o = 32; o > 0; o >>= 1) v += __shfl_xor(v, o);
  return v;
}

__device__ __forceinline__ void ln_rows(const float* src, const float* g, const float* b, float* dst32, hf* dst16, int nrows) {
  const int wave = blockIdx.x * 8 + (tidx() >> 6), nw = gridDim.x * 8, lane = tidx() & 63;
  f4 gg[4], bb[4];
  for (int i = 0; i < 4; ++i) { gg[i] = *(const f4*)(g + i * 256 + lane * 4); bb[i] = *(const f4*)(b + i * 256 + lane * 4); }
  for (int r = wave; r < nrows; r += nw) {
    f4 v[4]; float s = 0.f;
    for (int i = 0; i < 4; ++i) { v[i] = *(const f4*)(src + (long)r * 1024 + i * 256 + lane * 4); s += (v[i][0] + v[i][1]) + (v[i][2] + v[i][3]); }
    const float mu = wave_sum(s) * (1.0f / 1024.0f);
    float q = 0.f;
    for (int i = 0; i < 4; ++i) for (int j = 0; j < 4; ++j) { const float d = v[i][j] - mu; q += d * d; }
    const float rs = rsqrtf(wave_sum(q) * (1.0f / 1024.0f) + 1e-5f);
    for (int i = 0; i < 4; ++i) { f4 o; for (int j = 0; j < 4; ++j) o[j] = (v[i][j] - mu) * rs * gg[i][j] + bb[i][j];
      if (dst32) *(f4*)(dst32 + (long)r * 1024 + i * 256 + lane * 4) = o;
      *(h4*)(dst16 + (long)r * 1024 + i * 256 + lane * 4) = cvt4(o); }
  }
}

__device__ __forceinline__ void conv_w_job(const float* __restrict__ src, int ld, int K, hf* __restrict__ dst, int NBk  , int mode, int coloff) {
  float* tile = (float*)smem;
  const int nkb = K / 64, total = NBk * nkb, tid = tidx();
  for (int u = blockIdx.x; u < total; u += gridDim.x) {
    const int nb = u / nkb, kb = u % nkb;
    int c0;
    if (mode == 0) c0 = coloff + nb * 64;
    else { const int j = nb >> 2, sub = nb & 3; c0 = (sub < 2) ? (j * 128 + sub * 64) : (FFN + j * 128 + (sub - 2) * 64); }
    __syncthreads();
    for (int h = 0; h < 2; ++h) { const int kk = (tid >> 4) + h * 32, c4 = tid & 15;
      const f4 v = *(const f4*)(src + (long)(kb * 64 + kk) * ld + c0 + c4 * 4);
      for (int j = 0; j < 4; ++j) tile[kk * 65 + c4 * 4 + j] = v[j]; }
    __syncthreads();
    { const int n = tid >> 3, k8 = tid & 7; h8 o;
      const int rho = n & 31, ii = rho & 15, ns = (n & 32) + 8 * (ii >> 2) + 4 * (rho >> 4) + (ii & 3);
      for (int j = 0; j < 8; ++j) o[j] = (hf)tile[(k8 * 8 + j) * 65 + ns];
      *(h8*)(dst + (long)(nb * 64 + n) * K + kb * 64 + k8 * 8) = o; }
  }
}

__device__ __forceinline__ void convert_ffn(KP p, const float* w_in, const float* w_out, hf* din, hf* dout) {
  conv_w_job(w_in, 2 * FFN, 1024, din, 88, 1, 0);
  conv_w_job(w_out, 1024, FFN, dout, 16, 0, 0);
}
__device__ __forceinline__ void convert_mix(KP p, int l) {
  conv_w_job(p->in[6] + (long)l * 1024 * 7936, 7936, 1024, p->wmix, 124, 0, 0);
  conv_w_job(p->in[8] + (long)l * 512 * 1024, 1024, 512, p->pswa, 16, 0, 0);
  conv_w_job(p->in[19] + (long)l * 512 * 1024, 1024, 512, p->ps5, 16, 0, 0);
  conv_w_job(p->in[24] + (long)l * 512 * 1024, 1024, 512, p->pconv, 16, 0, 0);
  conv_w_job(p->in[30] + (long)l * 512 * 1024, 1024, 512, p->pdiff, 16, 0, 0);
  conv_w_job(p->in[17] + (long)l * 512 * 512, 512, 512, p->glu, 8, 0, 0);
  conv_w_job(p->in[31] + (long)l * 1024 * 1024, 1024, 1024, p->wout, 16, 0, 0);
}
__device__ __forceinline__ void convert_cross(KP p, int l) {
  conv_w_job(p->in[36] + (long)l * 1024 * 512, 512, 1024, p->wq, 8, 0, 0);
  conv_w_job(p->in[38] + (long)l * 512 * 1024, 1024, 512, p->wo, 16, 0, 0);
}

__device__ __forceinline__ void phase_init(KP p) {
  { const long n4 = (long)NTOK * 1024 / 4; const f4* s = (const f4*)p->in[0]; h4* d = (h4*)p->x16;
    for (long i = (long)blockIdx.x * 512 + tidx(); i < n4; i += (long)gridDim.x * 512) d[i] = cvt4(s[i]); }
  ln_rows(p->in[1], p->in[34], p->in[35], nullptr, p->memn, 4096);
  convert_ffn(p, p->in[2], p->in[3], p->w1in, p->w1out);
  for (int l = 0; l < 4; ++l) conv_w_job(p->in[37] + (long)l * 1024 * 1024, 1024, 1024, p->wkv + (long)l * 1024 * 1024, 16, 0, 0);
}

__device__ __forceinline__ h4 trrd(const hf* q) { return __builtin_bit_cast(h4, __builtin_amdgcn_ds_read_tr16_b64_v4i16((__attribute__((address_space(3))) s4v*)q)); }

template <int DK, int DV, int KW, bool ALIBI, int MASK>
__device__ __forceinline__ void attn_core(const hf* __restrict__ Kg, long kstride, const hf* __restrict__ Vg, long vstride, int T0, int T1,
                                          const hf* __restrict__ Qw, long qstride, int kcol, int q0, float c1, float c2,
                                          f4 (&O)[2][DV / 16], float (&m)[2], float (&l)[2]) {
  constexpr int KSTR = KW + 8, VSTR = DV + 8, KCH = KW / 8, VCH = DV / 8, NKL = 64 * KCH / 512, NVL = 64 * VCH / 512;
  hf* Ks = (hf*)smem; hf* Vs = Ks + 64 * KSTR;
  const int tid = tidx(), lane = tid & 63, fr = lane & 15, fq = lane >> 4;
  h8 qf[2][DK / 32];
#pragma unroll
  for (int qs = 0; qs < 2; ++qs)
#pragma unroll
    for (int ks = 0; ks < DK / 32; ++ks) qf[qs][ks] = *(const h8*)(Qw + (long)(qs * 16 + fr) * qstride + ks * 32 + fq * 8);
  h8 kreg[NKL], vreg[NVL];
#pragma unroll
  for (int i = 0; i < NKL; ++i) { const int idx = tid + i * 512, r = idx / KCH, c = idx % KCH; kreg[i] = *(const h8*)(Kg + (long)(T0 * 64 + r) * kstride + c * 8); }
#pragma unroll
  for (int i = 0; i < NVL; ++i) { const int idx = tid + i * 512, r = idx / VCH, c = idx % VCH; vreg[i] = *(const h8*)(Vg + (long)(T0 * 64 + r) * vstride + c * 8); }
#pragma unroll 1
  for (int T = T0; T < T1; ++T) {
    __syncthreads();
#pragma unroll
    for (int i = 0; i < NKL; ++i) { const int idx = tid + i * 512, r = idx / KCH, c = idx % KCH; *(h8*)(Ks + r * KSTR + c * 8) = kreg[i]; }
#pragma unroll
    for (int i = 0; i < NVL; ++i) { const int idx = tid + i * 512, r = idx / VCH, c = idx % VCH; *(h8*)(Vs + r * VSTR + c * 8) = vreg[i]; }
    __syncthreads();
    if (T + 1 < T1) {
#pragma unroll
      for (int i = 0; i < NKL; ++i) { const int idx = tid + i * 512, r = idx / KCH, c = idx % KCH; kreg[i] = *(const h8*)(Kg + (long)((T + 1) * 64 + r) * kstride + c * 8); }
#pragma unroll
      for (int i = 0; i < NVL; ++i) { const int idx = tid + i * 512, r = idx / VCH, c = idx % VCH; vreg[i] = *(const h8*)(Vg + (long)((T + 1) * 64 + r) * vstride + c * 8); }
    }
    bool rel = true;
    if (MASK >= 1) rel = (T * 64 <= q0 + 31);
    if (MASK == 2) rel = rel && (T * 64 + 63 >= q0 - 127);
    if (rel) {
      f4 S[2][4];
#pragma unroll
      for (int kt = 0; kt < 4; ++kt) {
#pragma unroll
        for (int qs = 0; qs < 2; ++qs) S[qs][kt] = (f4){0.f, 0.f, 0.f, 0.f};
#pragma unroll
        for (int ks = 0; ks < DK / 32; ++ks) {
          const h8 kf = *(const h8*)(Ks + (kt * 16 + fr) * KSTR + kcol + ks * 32 + fq * 8);
#pragma unroll
          for (int qs = 0; qs < 2; ++qs) S[qs][kt] = __builtin_amdgcn_mfma_f32_16x16x32_f16(kf, qf[qs][ks], S[qs][kt], 0, 0, 0);
        }
      }
      h8 pf[2][2];
#pragma unroll
      for (int qs = 0; qs < 2; ++qs) {
        const int qp = q0 + qs * 16 + fr;
        float mx = m[qs];
#pragma unroll
        for (int kt = 0; kt < 4; ++kt)
#pragma unroll
          for (int jj = 0; jj < 4; ++jj) {
            const int kp = T * 64 + kt * 16 + fq * 4 + jj;
            float s = S[qs][kt][jj] * c1;
            if (ALIBI) s -= c2 * (float)(qp - kp);
            if (MASK == 1) s = (kp <= qp) ? s : -1e30f;
            if (MASK == 2) s = (kp <= qp && qp - kp < 128) ? s : -1e30f;
            S[qs][kt][jj] = s; mx = fmaxf(mx, s);
          }
        mx = fmaxf(mx, __shfl_xor(mx, 16)); mx = fmaxf(mx, __shfl_xor(mx, 32));
        const float alpha = __builtin_amdgcn_exp2f(m[qs] - mx); m[qs] = mx;
        float ps = 0.f;
#pragma unroll
        for (int kt = 0; kt < 4; ++kt)
#pragma unroll
          for (int jj = 0; jj < 4; ++jj) { const float pv = __builtin_amdgcn_exp2f(S[qs][kt][jj] - mx); ps += pv; S[qs][kt][jj] = pv; }
        l[qs] = l[qs] * alpha + ps;
#pragma unroll
        for (int et = 0; et < DV / 16; ++et) O[qs][et] *= alpha;
#pragma unroll
        for (int pr = 0; pr < 2; ++pr)
#pragma unroll
          for (int jj = 0; jj < 4; ++jj) { pf[qs][pr][jj] = (hf)S[qs][2 * pr][jj]; pf[qs][pr][4 + jj] = (hf)S[qs][2 * pr + 1][jj]; }
      }
#pragma unroll
      for (int pr = 0; pr < 2; ++pr)
#pragma unroll
        for (int et = 0; et < DV / 16; ++et) {
          const h4 v0 = trrd(Vs + (pr * 32 + fq * 4 + (fr >> 2)) * VSTR + et * 16 + (fr & 3) * 4);
          const h4 v1 = trrd(Vs + (pr * 32 + 16 + fq * 4 + (fr >> 2)) * VSTR + et * 16 + (fr & 3) * 4);
          h8 vf; vf[0] = v0[0]; vf[1] = v0[1]; vf[2] = v0[2]; vf[3] = v0[3]; vf[4] = v1[0]; vf[5] = v1[1]; vf[6] = v1[2]; vf[7] = v1[3];
#pragma unroll
          for (int qs = 0; qs < 2; ++qs) O[qs][et] = __builtin_amdgcn_mfma_f32_16x16x32_f16(vf, pf[qs][pr], O[qs][et], 0, 0, 0);
        }
    }
  }
}

__device__ __forceinline__ void swa_unit(KP p, int l, int u) {
  const int hp = u & 1, n = (u >> 1) & 15, g = (u >> 5) & 1, b = u >> 6;
  const int w = tidx() >> 6, lane = tidx() & 63, fr = lane & 15, fq = lane >> 4;
  const int hq = g * 4 + hp * 2 + (w >> 2), q0 = n * 128 + (w & 3) * 32;
  const hf* Kg = p->akv + (long)b * SEQ * 256 + g * 64; const hf* Vg = Kg + 128;
  hf* Qw = p->aq + ((long)b * SEQ + q0) * 512 + hq * 64;
  hf* Ow = p->swo + ((long)b * SEQ + q0) * 512 + hq * 64;
  const float slope = exp2f(-(float)(hq + 1));
  f4 O[2][4]; float m[2], ls[2];
  const float sink = p->in[7][l * 8 + hq] * LOG2E;
  for (int qs = 0; qs < 2; ++qs) { m[qs] = sink; ls[qs] = (fq == 0) ? 1.f : 0.f; for (int et = 0; et < 4; ++et) O[qs][et] = (f4){0.f, 0.f, 0.f, 0.f}; }
  const int T0 = (2 * n - 2) < 0 ? 0 : (2 * n - 2), T1 = 2 * n + 2;
  attn_core<64, 64, 64, true, 2>(Kg, 256, Vg, 256, T0, T1, Qw, 512, 0, q0, 0.125f * LOG2E, slope * LOG2E, O, m, ls);
  for (int qs = 0; qs < 2; ++qs) {
    float lt = ls[qs]; lt += __shfl_xor(lt, 16); lt += __shfl_xor(lt, 32);
    const float inv = 1.0f / lt;
    for (int et = 0; et < 4; ++et) *(h4*)(Ow + (long)(qs * 16 + fr) * 512 + et * 16 + fq * 4) = cvt4(O[qs][et] * inv);
  }
}

__device__ __forceinline__ void diff_unit(KP p, int l, int u) {
  const int n = 15 - (u >> 6), h = u & 3, b = (u >> 2) & 15;
  const int w = tidx() >> 6, lane = tidx() & 63, fr = lane & 15, fq = lane >> 4;
  const int comp = w & 1, q0 = n * 128 + (w >> 1) * 32;
  const hf* Kg = p->dk + (long)b * SEQ * 512 + h * 128; const hf* Vg = p->dv + (long)b * SEQ * 512 + h * 128;
  hf* Qrow = p->dq + ((long)b * SEQ + q0) * 512 + h * 128;
  hf* Orow = p->dfo + ((long)b * SEQ + q0) * 512 + h * 128;
  const float slope = exp2f(-2.0f * (float)(h + 1));
  const float lambda_init = 0.8f - 0.6f * expf(-0.3f * (float)l);
  float lam;
  { const float a = p->in[25][l * 64 + lane] * p->in[26][l * 64 + lane], c = p->in[27][l * 64 + lane] * p->in[28][l * 64 + lane];
    lam = expf(wave_sum(a)) - expf(wave_sum(c)) + lambda_init; }
  f4 O[2][8]; float m[2], ls[2];
  for (int qs = 0; qs < 2; ++qs) { m[qs] = -1e30f; ls[qs] = 0.f; for (int et = 0; et < 8; ++et) O[qs][et] = (f4){0.f, 0.f, 0.f, 0.f}; }
  attn_core<64, 128, 128, true, 1>(Kg, 512, Vg, 512, 0, 2 * n + 2, Qrow + comp * 64, 512, comp * 64, q0, 0.125f * LOG2E, slope * LOG2E, O, m, ls);
  float inv[2];
  for (int qs = 0; qs < 2; ++qs) { float lt = ls[qs]; lt += __shfl_xor(lt, 16); lt += __shfl_xor(lt, 32); inv[qs] = 1.0f / lt; }
  __syncthreads();
  float* XS = (float*)smem + (w >> 1) * 4096;
  if (comp == 1) {
    for (int qs = 0; qs < 2; ++qs) for (int et = 0; et < 8; ++et) for (int jj = 0; jj < 4; ++jj) XS[((qs * 8 + et) * 4 + jj) * 64 + lane] = O[qs][et][jj] * inv[qs];
  }
  __syncthreads();
  if (comp == 0) {
    const float* ng = p->in[29] + l * 128;
    for (int qs = 0; qs < 2; ++qs) {
      float ss = 0.f;
      for (int et = 0; et < 8; ++et) for (int jj = 0; jj < 4; ++jj) { const float v = O[qs][et][jj] * inv[qs] - lam * XS[((qs * 8 + et) * 4 + jj) * 64 + lane]; O[qs][et][jj] = v; ss += v * v; }
      ss += __shfl_xor(ss, 16); ss += __shfl_xor(ss, 32);
      const float r = rsqrtf(ss * (1.0f / 128.0f) + 1e-5f) * (1.0f - lambda_init);
      for (int et = 0; et < 8; ++et) { const f4 g4 = *(const f4*)(ng + et * 16 + fq * 4); f4 v = O[qs][et];
        for (int jj = 0; jj < 4; ++jj) v[jj] = v[jj] * r * g4[jj];
        *(h4*)(Orow + (long)(qs * 16 + fr) * 512 + et * 16 + fq * 4) = cvt4(v); }
    }
  }
}

__device__ __forceinline__ void cross_unit(KP p, int l, int u) {
  const int qb = u & 7, h = (u >> 3) & 3, b = u >> 5;
  const int w = tidx() >> 6, lane = tidx() & 63, fr = lane & 15, fq = lane >> 4;
  const int q0 = qb * 256 + w * 32;
  const hf* Kg = p->kvc + (long)l * 4096 * 1024 + (long)b * 256 * 1024 + h * 128; const hf* Vg = Kg + 512;
  const hf* Qw = p->aq + ((long)b * SEQ + q0) * 512 + h * 128;
  hf* Ow = p->dq + ((long)b * SEQ + q0) * 512 + h * 128;
  f4 O[2][8]; float m[2], ls[2];
  for (int qs = 0; qs < 2; ++qs) { m[qs] = -1e30f; ls[qs] = 0.f; for (int et = 0; et < 8; ++et) O[qs][et] = (f4){0.f, 0.f, 0.f, 0.f}; }
  attn_core<128, 128, 128, false, 0>(Kg, 1024, Vg, 1024, 0, 4, Qw, 512, 0, q0, 0.08838834764831845f * LOG2E, 0.f, O, m, ls);
  for (int qs = 0; qs < 2; ++qs) {
    float lt = ls[qs]; lt += __shfl_xor(lt, 16); lt += __shfl_xor(lt, 32);
    const float inv = 1.0f / lt;
    for (int et = 0; et < 8; ++et) *(h4*)(Ow + (long)(qs * 16 + fr) * 512 + et * 16 + fq * 4) = cvt4(O[qs][et] * inv);
  }
}

__device__ __forceinline__ void s5_unit(KP p, int l, int u) {
  const int b = u >> 2, w = tidx() >> 6, g = (u & 3) * 8 + w, lane = tidx() & 63, fr = lane & 15, fq = lane >> 4;
  float* BuS = (float*)(smem + w * 12800);
  float* Yt = BuS + 16 * 132;
  const int lg = l * 32 + g;
  const float step = expf(p->in[11][lg]);
  float abr, abi;
  { const float ar = p->in[9][lg * 64 + lane], ai = p->in[10][lg * 64 + lane]; const float mag = expf(ar * step); abr = mag * cosf(ai * step); abi = mag * sinf(ai * step); }
  h8 bfr[8];
#pragma unroll
  for (int nt = 0; nt < 8; ++nt) {
    const int pp = (nt & 3) * 16 + fr;
    const float ar = p->in[9][lg * 64 + pp], ai = p->in[10][lg * 64 + pp]; const float mag = expf(ar * step);
    const float nr = mag * cosf(ai * step) - 1.0f, ni = mag * sinf(ai * step), den = ar * ar + ai * ai;
    const float cr = (nr * ar + ni * ai) / den, ci = (ni * ar - nr * ai) / den;
    const float* brp = p->in[12] + ((long)lg * 64 + pp) * 16 + (fq & 1) * 8; const float* bip = p->in[13] + ((long)lg * 64 + pp) * 16 + (fq & 1) * 8;
#pragma unroll
    for (int s = 0; s < 8; ++s) { const float v = (nt < 4) ? (cr * brp[s] - ci * bip[s]) : (cr * bip[s] + ci * brp[s]); bfr[nt][s] = (fq < 2) ? (hf)v : (hf)0.0f; }
  }
  h8 cfr[4];
#pragma unroll
  for (int ks = 0; ks < 4; ++ks) {
    const float* src = (ks < 2 ? p->in[14] : p->in[15]) + ((long)lg * 16 + fr) * 64 + (ks & 1) * 32 + fq * 8;
    const float sg = ks < 2 ? 1.0f : -1.0f;
#pragma unroll
    for (int j = 0; j < 8; ++j) cfr[ks][j] = (hf)(sg * src[j]);
  }
  h8 dfr;
  { const float dd = p->in[16][l * 512 + g * 16 + fr];
#pragma unroll
    for (int s = 0; s < 8; ++s) dfr[s] = (fq < 2 && (fq & 1) * 8 + s == fr) ? (hf)dd : (hf)0.0f; }
  float xr = 0.f, xi = 0.f;
  const hf* up = p->su + (long)b * SEQ * 512 + g * 16 + (fq & 1) * 8;
  hf* yp = p->s5tmp + (long)b * SEQ * 512 + g * 16;
  h8 un = *(const h8*)(up + (long)fr * 512);
#pragma unroll 1
  for (int ch = 0; ch < 128; ++ch) {
    h8 uf = un;
    if (fq >= 2) { for (int s = 0; s < 8; ++s) uf[s] = (hf)0.0f; }
    if (ch < 127) un = *(const h8*)(up + (long)((ch + 1) * 16 + fr) * 512);
#pragma unroll
    for (int nt = 0; nt < 8; ++nt) {
      const f4 d = __builtin_amdgcn_mfma_f32_16x16x32_f16(uf, bfr[nt], (f4){0.f, 0.f, 0.f, 0.f}, 0, 0, 0);
#pragma unroll
      for (int jj = 0; jj < 4; ++jj) BuS[(fq * 4 + jj) * 132 + nt * 16 + fr] = d[jj];
    }
    __syncthreads();
    float br_[16], bi_[16];
#pragma unroll
    for (int t = 0; t < 16; ++t) { br_[t] = BuS[t * 132 + lane]; bi_[t] = BuS[t * 132 + 64 + lane]; }
#pragma unroll
    for (int t = 0; t < 16; ++t) {
      const float nxr = abr * xr - abi * xi + br_[t], nxi = abr * xi + abi * xr + bi_[t]; xr = nxr; xi = nxi;
      BuS[t * 132 + lane] = xr; BuS[t * 132 + 64 + lane] = xi;
    }
    __syncthreads();
    f4 y = (f4){0.f, 0.f, 0.f, 0.f};
#pragma unroll
    for (int ks = 0; ks < 4; ++ks) {
      const f4 xa = *(const f4*)(BuS + fr * 132 + ks * 32 + fq * 8), xb = *(const f4*)(BuS + fr * 132 + ks * 32 + fq * 8 + 4);
      h8 xf; xf[0] = (hf)xa[0]; xf[1] = (hf)xa[1]; xf[2] = (hf)xa[2]; xf[3] = (hf)xa[3]; xf[4] = (hf)xb[0]; xf[5] = (hf)xb[1]; xf[6] = (hf)xb[2]; xf[7] = (hf)xb[3];
      y = __builtin_amdgcn_mfma_f32_16x16x32_f16(xf, cfr[ks], y, 0, 0, 0);
    }
    y = __builtin_amdgcn_mfma_f32_16x16x32_f16(uf, dfr, y, 0, 0, 0);
#pragma unroll
    for (int jj = 0; jj < 4; ++jj) {
      const float v = y[jj], z = 0.7978845608028654f * (v + 0.044715f * v * v * v);
      const float th = 1.0f - 2.0f * __builtin_amdgcn_rcpf(__builtin_amdgcn_exp2f(2.8853900817779268f * z) + 1.0f);
      Yt[(fq * 4 + jj) * 20 + fr] = 0.5f * v * (1.0f + th);
    }
    __syncthreads();
    { const int t = lane >> 2, c4 = (lane & 3) * 4; const f4 v = *(const f4*)(Yt + t * 20 + c4);
      *(h4*)(yp + (long)(ch * 16 + t) * 512 + c4) = cvt4(v); }
  }
}

__device__ __forceinline__ void conv_unit(KP p, int l, int u) {
  const int b = u >> 5, t0 = (u & 31) * 64, tid = tidx(), w = tid >> 6, lane = tid & 63;
  hf* G = (hf*)smem;
  hf* Wc = (hf*)(smem + 96256);
  for (int idx = tid; idx < 94 * 64; idx += 512) {
    const int r = idx >> 6, c8 = idx & 63, t = t0 - 30 + r; h8 o;
    if (t >= 0) { const hf* src = p->cu + ((long)b * SEQ + t) * 1024 + c8 * 8; const h8 v = *(const h8*)src, gt = *(const h8*)(src + 512);
      for (int j = 0; j < 8; ++j) o[j] = (hf)((float)v[j] * sigmoidf_((float)gt[j])); }
    else { for (int j = 0; j < 8; ++j) o[j] = (hf)0.0f; }
    *(h8*)(G + r * 512 + c8 * 8) = o;
  }
  { const float* cw = p->in[20] + (long)l * 31 * 512; for (int idx = tid; idx < 31 * 512; idx += 512) Wc[idx] = (hf)cw[idx]; }
  __syncthreads();
  const float* cb = p->in[21] + l * 512 + lane * 8; const f4 b0 = *(const f4*)cb, b1 = *(const f4*)(cb + 4);
  const float* lg = p->in[22] + l * 512 + lane * 8; const float* lb = p->in[23] + l * 512 + lane * 8;
  const f4 g0 = *(const f4*)lg, g1 = *(const f4*)(lg + 4), c0 = *(const f4*)lb, c1 = *(const f4*)(lb + 4);
#pragma unroll 1
  for (int jp = 0; jp < 4; ++jp) {
    float a0[8], a1[8];
#pragma unroll
    for (int c = 0; c < 8; ++c) { a0[c] = c < 4 ? b0[c & 3] : b1[c & 3]; a1[c] = a0[c]; }
    const hf* gp = G + (w * 8 + jp * 2) * 512 + lane * 8;
    h8 wprev;
#pragma unroll
    for (int c = 0; c < 8; ++c) wprev[c] = (hf)0.0f;
#pragma unroll 8
    for (int k = 0; k < 32; ++k) {
      const h8 gv = *(const h8*)(gp + k * 512);
      h8 wv;
      if (k < 31) wv = *(const h8*)(Wc + k * 512 + lane * 8); else { for (int c = 0; c < 8; ++c) wv[c] = (hf)0.0f; }
#pragma unroll
      for (int c = 0; c < 8; ++c) { a0[c] += (float)gv[c] * (float)wv[c]; a1[c] += (float)gv[c] * (float)wprev[c]; }
      wprev = wv;
    }
#pragma unroll
    for (int jj = 0; jj < 2; ++jj) {
      float s = 0.f;
#pragma unroll
      for (int c = 0; c < 8; ++c) s += jj ? a1[c] : a0[c];
      const float mu = wave_sum(s) * (1.0f / 512.0f);
      float q = 0.f;
#pragma unroll
      for (int c = 0; c < 8; ++c) { const float d = (jj ? a1[c] : a0[c]) - mu; q += d * d; }
      const float rs = rsqrtf(wave_sum(q) * (1.0f / 512.0f) + 1e-5f);
      h8 o;
#pragma unroll
      for (int c = 0; c < 8; ++c) { const float gg = c < 4 ? g0[c & 3] : g1[c & 3], bb = c < 4 ? c0[c & 3] : c1[c & 3];
        const float v = ((jj ? a1[c] : a0[c]) - mu) * rs * gg + bb; o[c] = (hf)(v * sigmoidf_(v)); }
      *(h8*)(p->convout + ((long)b * SEQ + t0 + w * 8 + jp * 2 + jj) * 512 + lane * 8) = o;
    }
  }
}

__device__ __forceinline__ void phase_mixers(KP p, int l, int cidx) {
  volatile int* ctl = (volatile int*)(smem + CTL_OFF);
  const int NS5 = 64, NDIFF = 1024, NSWA = 1024, NCONV = 512, TOTAL = NS5 + NDIFF + NSWA + NCONV;
  for (;;) {
    __syncthreads();
    if (tidx() == 0) *ctl = (int)atomicAdd(p->counters + cidx, 1u);
    __syncthreads();
    const int it = *ctl;
    if (it >= TOTAL) break;
    if (it < NS5) s5_unit(p, l, it);
    else if (it < NS5 + NDIFF) diff_unit(p, l, it - NS5);
    else if (it < NS5 + NDIFF + NSWA) swa_unit(p, l, it - NS5 - NDIFF);
    else conv_unit(p, l, it - NS5 - NDIFF - NSWA);
  }
}
__device__ __forceinline__ void phase_cross_attn(KP p, int l) {
  for (int u = blockIdx.x; u < 512; u += gridDim.x) { __syncthreads(); cross_unit(p, l, u); }
}

__global__ void __launch_bounds__(512) fwd_megakernel(Params pv) {
  cg::grid_group grid = cg::this_grid();
  if (tidx() == 0) { const unsigned long long kp = (unsigned long long)__builtin_amdgcn_kernarg_segment_ptr();
    volatile __attribute__((address_space(3))) unsigned* s = (volatile __attribute__((address_space(3))) unsigned*)(smem + 136 * 1024 + 16);
    s[0] = (unsigned)kp; s[1] = (unsigned)(kp >> 32); s[4] = 0u; s[5] = 0u; }
  __syncthreads();
  if (tidx() == 0) (void)xb_add(&getp()->counters[XB_XCNT(xb_xcc_id())], 1u);
  phase_init(getp());
  grid.sync();
#pragma unroll 1
  for (int j = 0; j < 8; ++j) {
    const int l = j >> 1, second = j & 1;
    phase_ffn_a(getp(), getp()->w1in, j == 0);
    gbar();
    phase_resid(getp(), getp()->aq, FFN, getp()->w1out, FFN, 0.5f);
    gbar();
    ln_rows(getp()->out, getp()->in[second ? 43 : 4] + l * 1024, getp()->in[second ? 44 : 5] + l * 1024, j == 7 ? getp()->out : (float*)nullptr, getp()->x16, NTOK);
    if (!second) convert_mix(getp(), l);
    else if (l < 3) convert_ffn(getp(), getp()->in[2] + (long)(l + 1) * 1024 * 2 * FFN, getp()->in[3] + (long)(l + 1) * FFN * 1024, getp()->w1in, getp()->w1out);
    gbar();
    if (!second) {
      phase_mix_a(getp());
      gbar();
      phase_mixers(getp(), l, l);
      gbar();
      phase_s5_glu(getp(), l);
      gbar();
      phase_merge(getp());
      gbar();
      phase_resid(getp(), getp()->cu, 1024, getp()->wout, 1024, 1.0f);
      gbar();
      ln_rows(getp()->out, getp()->in[32] + l * 1024, getp()->in[33] + l * 1024, (float*)nullptr, getp()->x16, NTOK);
      convert_cross(getp(), l);
      gbar();
      phase_plain(getp()->x16, 1024, getp()->wq, 1024, getp()->aq, 512, 128, 2);
      gbar();
      phase_cross_attn(getp(), l);
      gbar();
      phase_resid(getp(), getp()->dq, 512, getp()->wo, 512, 1.0f);
      gbar();
      ln_rows(getp()->out, getp()->in[39] + l * 1024, getp()->in[40] + l * 1024, (float*)nullptr, getp()->x16, NTOK);
      convert_ffn(getp(), getp()->in[41] + (long)l * 1024 * 2 * FFN, getp()->in[42] + (long)l * FFN * 1024, getp()->w1in, getp()->w1out);
      gbar();
    }
  }
}

extern "C" void kernel_launch(void* const* d_in, const int* in_sizes, int n_in, void* d_out, int out_size, void* d_ws, size_t ws_size, hipStream_t stream) {
  Params p; memset(&p, 0, sizeof(p));
  for (int i = 0; i < 45; ++i) p.in[i] = (const float*)d_in[i];
  p.out = (float*)d_out;
  char* base = (char*)d_ws; size_t off = 0;
  auto carve = [&](size_t halves) { hf* r = (hf*)(base + off); off += (halves * 2 + 255) & ~(size_t)255; return r; };
  p.counters = (unsigned*)base; off = 16384;
  p.x16 = carve((size_t)NTOK * 1024);
  p.w1in = carve((size_t)5632 * 1024); p.w1out = carve((size_t)1024 * FFN);
  p.wmix = carve((size_t)7936 * 1024);
  p.pswa = carve(1024 * 512); p.ps5 = carve(1024 * 512); p.pconv = carve(1024 * 512); p.pdiff = carve(1024 * 512);
  p.glu = carve(512 * 512); p.wout = carve(1024 * 1024); p.wq = carve(512 * 1024); p.wo = carve(1024 * 512);
  p.wkv = carve((size_t)4 * 1024 * 1024); p.kvc = carve((size_t)4 * 4096 * 1024); p.memn = carve((size_t)4096 * 1024);
  p.aq = carve((size_t)NTOK * 512); p.akv = carve((size_t)NTOK * 256); p.dq = carve((size_t)NTOK * 512);
  p.dk = carve((size_t)NTOK * 512); p.dv = carve((size_t)NTOK * 512); p.su = carve((size_t)NTOK * 512); p.cu = carve((size_t)NTOK * 1024);
  p.s5tmp = carve((size_t)NTOK * 512); p.convout = carve((size_t)NTOK * 512);
  p.swo = carve((size_t)NTOK * 512); p.dfo = carve((size_t)NTOK * 512);
  static int grid_blocks = 0;
  if (!grid_blocks) {
    hipFuncSetAttribute((const void*)fwd_megakernel, hipFuncAttributeMaxDynamicSharedMemorySize, LDS_BYTES);
    int dev = 0, cus = 0, per_cu = 0;
    hipGetDevice(&dev);
    hipDeviceGetAttribute(&cus, hipDeviceAttributeMultiprocessorCount, dev);
    hipOccupancyMaxActiveBlocksPerMultiprocessor(&per_cu, fwd_megakernel, 512, LDS_BYTES);
    if (per_cu > 1) per_cu = 1;
    grid_blocks = cus * per_cu;
    if (grid_blocks <= 0) grid_blocks = 256;
  }
  (void)hipMemsetAsync(d_ws, 0, 16384, stream);
  void* args[] = {&p};
  hipError_t e = hipLaunchCooperativeKernel((const void*)fwd_megakernel, dim3(grid_blocks), dim3(512), args, LDS_BYTES, stream);
  if (e != hipSuccess) fprintf(stderr, "cooperative launch failed: %s (grid %d)\n", hipGetErrorString(e), grid_blocks);
}
```

```cpp
#include <hip/hip_runtime.h>
#include <hip/hip_cooperative_groups.h>
#include <cstdio>
#include <cstring>
namespace cg = cooperative_groups;

typedef _Float16 hf;
typedef _Float16 h8 __attribute__((ext_vector_type(8)));
typedef _Float16 h4 __attribute__((ext_vector_type(4)));
typedef short s4v __attribute__((ext_vector_type(4)));
typedef float f4 __attribute__((ext_vector_type(4)));

constexpr int NTOK = 32768, SEQ = 2048, FFN = 2816;
constexpr int LDS_BYTES = 140 * 1024;
constexpr int CTL_OFF = 136 * 1024;
constexpr float LOG2E = 1.4426950408889634f;
constexpr float DN_ALPHA = 1.681792830507429f;

struct Params {
  const float* in[45];
  float* out;
  hf *x16, *w1in, *w1out, *wmix, *pswa, *ps5, *pconv, *pdiff, *glu, *wout, *wq, *wo, *wkv, *kvc, *memn;
  hf *aq, *akv, *dq, *dk, *dv, *su, *cu, *s5tmp, *convout, *swo, *dfo;
  unsigned* counters;
  unsigned pad_;
  unsigned pad2_;
};

extern __shared__ __attribute__((aligned(16))) unsigned char smem[];
__device__ __forceinline__ int tidx() { int t = __builtin_amdgcn_workitem_id_x(); asm volatile("" : "+v"(t)); return t; }
typedef const __attribute__((address_space(4))) Params* KP;
__device__ __forceinline__ KP getp() {
  volatile __attribute__((address_space(3))) unsigned* s = (volatile __attribute__((address_space(3))) unsigned*)(smem + 136 * 1024 + 16);
  const unsigned lo = __builtin_amdgcn_readfirstlane(s[0]), hi = __builtin_amdgcn_readfirstlane(s[1]);
  unsigned long long v = ((unsigned long long)hi << 32) | lo;
  asm volatile("" : "+s"(v));
  return (KP)v;
}

#define XB_TMO      128
#define XB_XCNT(j)  (256  + 64 * (j))
#define XB_XSUB(j)  (1280 + 64 * (j))
#define XB_XGEN(j)  (2304 + 64 * (j))
#define XB_TOP      3328
#define XB_TOPGEN   3392
#define XB_SPIN_CAP (1u << 20)
__device__ __forceinline__ unsigned xb_ld(unsigned* p)              { return __hip_atomic_load(p, __ATOMIC_RELAXED, __HIP_MEMORY_SCOPE_AGENT); }
__device__ __forceinline__ unsigned xb_add(unsigned* p, unsigned v) { return __hip_atomic_fetch_add(p, v, __ATOMIC_RELAXED, __HIP_MEMORY_SCOPE_AGENT); }
__device__ __forceinline__ unsigned xb_xcc_id() { return (unsigned)__builtin_amdgcn_s_getreg((3 << 11) | 20) & 0xFu; }
#define XB_SPIN(cond, bar) do { unsigned _sp = 0; while (cond) { __builtin_amdgcn_s_sleep(1); \
    if ((++_sp & 255u) == 0u) { if (xb_ld(&(bar)[XB_TMO])) break; if (_sp > XB_SPIN_CAP) { atomicAdd(&(bar)[XB_TMO], 1u); break; } } } } while (0)
__device__ __forceinline__ void xcd_barrier_complete(unsigned* bar, unsigned x, unsigned& nloc, unsigned& nx) {
  const unsigned G = gridDim.x;
  unsigned sum, cnt, mine, sp = 0u;
  for (;;) {
    sum = 0u; cnt = 0u; mine = 0u;
#pragma unroll
    for (unsigned j = 0; j < 16; ++j) { const unsigned c = xb_ld(&bar[XB_XCNT(j)]); sum += c; cnt += (c > 0u) ? 1u : 0u; mine = (j == x) ? c : mine; }
    if (sum == G) break;
    __builtin_amdgcn_s_sleep(1);
    if ((++sp & 255u) == 0u) { if (xb_ld(&bar[XB_TMO])) break; if (sp > XB_SPIN_CAP) { atomicAdd(&bar[XB_TMO], 1u); break; } }
  }
  nloc = mine > 0u ? mine : 1u; nx = cnt > 0u ? cnt : 1u;
}
__device__ __forceinline__ void gbar() {
  asm volatile("s_waitcnt vmcnt(0)" ::: "memory");
  __syncthreads();
  if (tidx() == 0) {
    unsigned* bar = getp()->counters;
    volatile __attribute__((address_space(3))) unsigned* st = (volatile __attribute__((address_space(3))) unsigned*)(smem + 136 * 1024 + 32);
    const unsigned x = xb_xcc_id();
    __builtin_amdgcn_s_waitcnt(0);
    unsigned nloc = st[0], nx = st[1];
    if (nloc == 0u) { xcd_barrier_complete(bar, x, nloc, nx); st[0] = nloc; st[1] = nx; }
    const unsigned old = xb_add(&bar[XB_XSUB(x)], 1u);
    const unsigned gen = old / nloc;
    if (old + 1u == (gen + 1u) * nloc) {
      __builtin_amdgcn_fence(__ATOMIC_RELEASE, "agent");
      asm volatile("s_waitcnt vmcnt(0)" ::: "memory");
      const unsigned og = xb_add(&bar[XB_TOP], 1u);
      const unsigned tg = og / nx;
      if (og + 1u == (tg + 1u) * nx) xb_add(&bar[XB_TOPGEN], 1u);
      else XB_SPIN(xb_ld(&bar[XB_TOPGEN]) == tg, bar);
      __builtin_amdgcn_fence(__ATOMIC_ACQUIRE, "agent");
      xb_add(&bar[XB_XGEN(x)], 1u);
      asm volatile("s_waitcnt vmcnt(0)" ::: "memory");
    } else {
      XB_SPIN(xb_ld(&bar[XB_XGEN(x)]) == gen, bar);
      __builtin_amdgcn_fence(__ATOMIC_ACQUIRE, "agent");
      asm volatile("s_waitcnt vmcnt(0)" ::: "memory");
    }
  }
  __syncthreads();
}

constexpr int BM = 256, BK = 64, HALFT = 128, HT = HALFT * BK;
__device__ __forceinline__ int lds_byte(int r, int c) {
  int st = (r >> 4) * 2 + (c >> 5), rr = r & 15, cc = c & 31, ob = rr * 64 + cc * 2;
  return st * 1024 + (ob ^ (((ob >> 9) & 1) << 5));
}
__device__ __forceinline__ void stage_rc(int b, int& R, int& C) {
  int st = b / 1024, sb = b % 1024, swz = sb ^ (((sb >> 9) & 1) << 5);
  R = (st >> 1) * 16 + swz / 64; C = (st & 1) * 32 + (swz % 64) / 2;
}
__device__ __forceinline__ bool tile_order(int i, int nM, int nN, int& pm, int& pn) {
  const int nwg = nM * nN; const int L = i * (int)gridDim.x + (int)blockIdx.x; if (L >= nwg) return false;
  int wgid = (int)L; { const int q = nwg / 8, r = nwg % 8, xcd = wgid % 8, off = wgid / 8; wgid = (xcd < r ? xcd * (q + 1) : r * (q + 1) + (xcd - r) * q) + off; }
  const int nig = 8 * nN, gid = wgid / nig, fm = gid * 8, gsz = (nM - fm) < 8 ? (nM - fm) : 8;
  pm = fm + ((wgid % nig) % gsz); pn = (wgid % nig) / gsz; return true;
}

#define LAS __attribute__((address_space(3)))
constexpr int HTB = HALFT * BK * 2;
struct GU { const char* A; const char* B; int lda, ldb, nt, brow, bcol, aux; };

template <class Prov, class Epi>
__device__ __forceinline__ void gemm_stream(Prov prov, Epi epi) {
  LAS unsigned char* lds = (LAS unsigned char*)smem;
  const int tid = tidx();
  const int wid = __builtin_amdgcn_readfirstlane(tid >> 6), lane = tid & 63, wr = wid >> 2, wc = wid & 3, fr = lane & 15, fq = lane >> 4;
  int sR[2], sC[2];
#pragma unroll
  for (int i = 0; i < 2; ++i) stage_rc(tid * 16 + i * 8192, sR[i], sC[i]);
  const size_t kstep = (size_t)(BK * 2);
  const unsigned ldsw = (unsigned)wid * 1024u;
  const int aoff = lds_byte(wr * 64 + fr, fq * 8), boff = lds_byte(wc * 32 + fr, fq * 8);
  GU cur, nxt;
  if (!prov(0, cur)) return;
  int ui = 0;
#define GSA(b, h) (((b)*2 + (h)) * HTB)
#define GSB(b, h) ((4 + (b)*2 + (h)) * HTB)
#define STAGE(bufoff, gbase, ld) do { _Pragma("unroll") for (int _i = 0; _i < 2; ++_i) \
    __builtin_amdgcn_global_load_lds((const unsigned*)((const char*)(gbase) + (unsigned)((sR[_i] * (ld) + sC[_i]) * 2)), (LAS unsigned*)(lds + (bufoff) + ldsw + _i * 8192), 16, 0, 0); } while (0)
#define LDA(dst, b, h) do { _Pragma("unroll") for (int m = 0; m < 4; ++m) _Pragma("unroll") for (int k = 0; k < 2; ++k) dst[m][k] = *(const LAS h8*)(lds + GSA(b, h) + aoff + m * 2048 + k * 1024); } while (0)
#define LDB(dst, b, h) do { _Pragma("unroll") for (int n = 0; n < 2; ++n) _Pragma("unroll") for (int k = 0; k < 2; ++k) dst[n][k] = *(const LAS h8*)(lds + GSB(b, h) + boff + n * 2048 + k * 1024); } while (0)
#define MMA(ai, bj, At_, Bt_) do { __builtin_amdgcn_s_setprio(1); _Pragma("unroll") for (int m = 0; m < 4; ++m) _Pragma("unroll") for (int n = 0; n < 2; ++n) _Pragma("unroll") for (int k = 0; k < 2; ++k) \
      acc[ai][bj][m][n] = __builtin_amdgcn_mfma_f32_16x16x32_f16(Bt_[n][k], At_[m][k], acc[ai][bj][m][n], 0, 0, 0); \
    __builtin_amdgcn_s_setprio(0); } while (0)
#define WAIT_V(n) asm volatile("s_waitcnt vmcnt(" #n ")" ::: "memory")
#define WAIT_L(n) asm volatile("s_waitcnt lgkmcnt(" #n ")" ::: "memory")
#define BAR __builtin_amdgcn_s_barrier()
#define SCHED __builtin_amdgcn_sched_barrier(0)
#define ZERO_ACC _Pragma("unroll") for (int a = 0; a < 2; ++a) _Pragma("unroll") for (int b = 0; b < 2; ++b) _Pragma("unroll") for (int m = 0; m < 4; ++m) _Pragma("unroll") for (int n = 0; n < 2; ++n) acc[a][b][m][n] = (f4){0.f, 0.f, 0.f, 0.f}
  f4 acc[2][2][4][2];
  ZERO_ACC;
  h8 At[4][2], B0[2][2], B1[2][2];
  { const size_t hA = (size_t)HALFT * cur.lda * 2, hB = (size_t)HALFT * cur.ldb * 2;
    STAGE(GSB(0, 0), cur.B, cur.ldb); STAGE(GSB(0, 1), cur.B + hB, cur.ldb); STAGE(GSA(0, 0), cur.A, cur.lda); STAGE(GSA(0, 1), cur.A + hA, cur.lda);
    if (wr == 1) BAR;
    WAIT_V(2); BAR;
    STAGE(GSB(1, 0), cur.B + kstep, cur.ldb); STAGE(GSA(1, 0), cur.A + kstep, cur.lda); STAGE(GSB(1, 1), cur.B + hB + kstep, cur.ldb);
    WAIT_V(6); BAR; }
#pragma unroll 1
  for (;;) {
    const bool has_next = prov(ui + 1, nxt);
    if (!has_next) nxt = cur;
    const int nt = cur.nt;
    const size_t hA = (size_t)HALFT * cur.lda * 2;
#pragma unroll 1
    for (int t = 0; t < nt; t += 2) {
      const bool last = (t + 2 >= nt);
      const char* a1 = cur.A + (size_t)(t + 1) * kstep + hA;
      const char* a2 = last ? nxt.A : cur.A + (size_t)(t + 2) * kstep;
      const char* b2 = last ? nxt.B : cur.B + (size_t)(t + 2) * kstep;
      const int lda2 = last ? nxt.lda : cur.lda, ldb2 = last ? nxt.ldb : cur.ldb;
      const size_t hA2 = (size_t)HALFT * lda2 * 2, hB2 = (size_t)HALFT * ldb2 * 2;
      LDB(B0, 0, 0); LDB(B1, 0, 1); SCHED; LDA(At, 0, 0); STAGE(GSA(1, 1), a1, cur.lda);
      WAIT_V(8); WAIT_L(0); BAR; MMA(0, 0, At, B0); MMA(0, 1, At, B1); BAR; SCHED;
      LDA(At, 0, 1); STAGE(GSB(0, 0), b2, ldb2); STAGE(GSB(0, 1), b2 + hB2, ldb2); STAGE(GSA(0, 0), a2, lda2);
      WAIT_V(8); WAIT_L(0); BAR; MMA(1, 0, At, B0); MMA(1, 1, At, B1); BAR; SCHED;
      LDB(B0, 1, 0); LDB(B1, 1, 1); SCHED; LDA(At, 1, 0); STAGE(GSA(0, 1), a2 + hA2, lda2);
      WAIT_V(8); WAIT_L(0); BAR; MMA(0, 0, At, B0); MMA(0, 1, At, B1); BAR; SCHED;
      LDA(At, 1, 1); STAGE(GSB(1, 0), b2 + kstep, ldb2); STAGE(GSB(1, 1), b2 + hB2 + kstep, ldb2); STAGE(GSA(1, 0), a2 + kstep, lda2);
      WAIT_V(8); WAIT_L(0); BAR; MMA(1, 0, At, B0); MMA(1, 1, At, B1); BAR; SCHED;
    }
    if (wr == 0) BAR;
    epi(acc, cur, wr, wc, fr, fq);
    ZERO_ACC;
    if (!has_next) break;
    cur = nxt; ++ui;
    if (wr == 1) BAR;
  }
  __syncthreads();
#undef GSA
#undef GSB
#undef STAGE
#undef LDA
#undef LDB
#undef MMA
#undef ZERO_ACC
}

#define EPI_ARGS const f4 (&acc)[2][2][4][2], const GU& d, int wr, int wc, int fr, int fq
#define EPI_ROWS _Pragma("unroll") for (int ai = 0; ai < 2; ++ai) _Pragma("unroll") for (int m = 0; m < 4; ++m)
#define EPI_COLS _Pragma("unroll") for (int bj = 0; bj < 2; ++bj) _Pragma("unroll") for (int n = 0; n < 2; ++n)
#define AINL __attribute__((always_inline))

__device__ __forceinline__ float sigmoidf_(float x) { return __builtin_amdgcn_rcpf(1.0f + __builtin_amdgcn_exp2f(-1.4426950408889634f * x)); }
__device__ __forceinline__ h4 cvt4(f4 v) { h4 r; r[0] = (hf)v[0]; r[1] = (hf)v[1]; r[2] = (hf)v[2]; r[3] = (hf)v[3]; return r; }
__device__ __forceinline__ h8 cvt8(f4 a, f4 b) { h8 r; r[0] = (hf)a[0]; r[1] = (hf)a[1]; r[2] = (hf)a[2]; r[3] = (hf)a[3]; r[4] = (hf)b[0]; r[5] = (hf)b[1]; r[6] = (hf)b[2]; r[7] = (hf)b[3]; return r; }
#define EPI_BJ _Pragma("unroll") for (int bj = 0; bj < 2; ++bj)
__device__ __forceinline__ void set_gu(GU& d, const hf* A, int lda, const hf* B, int ldb, int K, int brow, int bcol, int aux) {
  d.A = (const char*)(A + (size_t)brow * lda); d.B = (const char*)(B + (size_t)bcol * ldb); d.lda = lda; d.ldb = ldb; d.nt = K / BK; d.brow = brow; d.bcol = bcol; d.aux = aux;
}

__device__ __forceinline__ void phase_ffn_a(KP p, const hf* w_in, bool with_kv) {
  hf* hidden = p->aq; hf* kvc = p->kvc;
  const hf* x16 = p->x16; const hf* memn = p->memn; const hf* wkv = p->wkv;
  const int nA = 128 * 22, total = nA + (with_kv ? 256 : 0);
  gemm_stream([&](int i, GU& d) AINL -> bool {
      const int L = i * (int)gridDim.x + (int)blockIdx.x; if (L >= total) return false;
      if (L < nA) {
        int wgid = (int)L; const int q = nA / 8, off = wgid / 8, xcd = wgid % 8; wgid = xcd * q + off;
        const int nig = 8 * 22, gid = wgid / nig, fm = gid * 8, pm = fm + ((wgid % nig) % 8), pn = (wgid % nig) / 8;
        set_gu(d, x16, 1024, w_in, 1024, 1024, pm * 256, pn * 256, 0);
      } else {
        const int t = (int)L - nA, l = t >> 6, pm = (t & 63) >> 2, pn = t & 3;
        set_gu(d, memn, 1024, wkv + (size_t)l * 1024 * 1024, 1024, 1024, pm * 256, pn * 256, 1 + l);
      }
      return true; },
    [&](EPI_ARGS) AINL {
      if (d.aux == 0) {
        EPI_ROWS { const long row = d.brow + ai * 128 + wr * 64 + m * 16 + fr;
          f4 v[2];
          _Pragma("unroll") for (int n = 0; n < 2; ++n) { const f4 g = acc[ai][0][m][n], u = acc[ai][1][m][n];
            _Pragma("unroll") for (int j = 0; j < 4; ++j) v[n][j] = g[j] * sigmoidf_(g[j]) * u[j]; }
          *(h8*)(hidden + row * FFN + (d.bcol >> 1) + wc * 32 + fq * 8) = cvt8(v[0], v[1]); }
      } else {
        hf* dst = kvc + (size_t)(d.aux - 1) * 4096 * 1024;
        EPI_ROWS { const long row = d.brow + ai * 128 + wr * 64 + m * 16 + fr;
          EPI_BJ { *(h8*)(dst + row * 1024 + d.bcol + bj * 128 + wc * 32 + fq * 8) = cvt8(acc[ai][bj][m][0], acc[ai][bj][m][1]); } }
      } });
}

__device__ __forceinline__ void phase_resid(KP p, const hf* A, int lda, const hf* Wt, int K, float scale) {
  hf* y16 = p->s5tmp; const hf* res = p->x16;
  gemm_stream([&](int i, GU& d) AINL -> bool { int pm, pn; if (!tile_order(i, 128, 4, pm, pn)) return false; set_gu(d, A, lda, Wt, K, K, pm * 256, pn * 256, 0); return true; },
    [&](EPI_ARGS) AINL {
      EPI_ROWS { const long row = d.brow + ai * 128 + wr * 64 + m * 16 + fr;
        EPI_BJ { const long o = row * 1024 + d.bcol + bj * 128 + wc * 32 + fq * 8;
          const h8 r = *(const h8*)(res + o); f4 v0 = acc[ai][bj][m][0], v1 = acc[ai][bj][m][1];
          _Pragma("unroll") for (int j = 0; j < 4; ++j) { v0[j] = DN_ALPHA * (float)r[j] + scale * v0[j]; v1[j] = DN_ALPHA * (float)r[4 + j] + scale * v1[j]; }
          *(h8*)(y16 + o) = cvt8(v0, v1); } } });
}

__device__ __forceinline__ void phase_mix_a(KP p) {
  gemm_stream([&](int i, GU& d) AINL -> bool { int pm, pn; if (!tile_order(i, 128, 15, pm, pn)) return false; KP q = getp(); set_gu(d, q->x16, 1024, q->wmix, 1024, 1024, pm * 256, pn * 256, pn); return true; },
    [&](EPI_ARGS) AINL {
      const int pn = d.aux; hf* dst; int ldc, coff; KP q = getp();
      if (pn < 2) { dst = q->aq; ldc = 512; coff = pn * 256; }
      else if (pn == 2) { dst = q->akv; ldc = 256; coff = 0; }
      else if (pn < 5) { dst = q->dq; ldc = 512; coff = (pn - 3) * 256; }
      else if (pn < 7) { dst = q->dk; ldc = 512; coff = (pn - 5) * 256; }
      else if (pn < 9) { dst = q->dv; ldc = 512; coff = (pn - 7) * 256; }
      else if (pn < 11) { dst = q->su; ldc = 512; coff = (pn - 9) * 256; }
      else { dst = q->cu; ldc = 1024; coff = (pn - 11) * 256; }
      EPI_ROWS { const long row = d.brow + ai * 128 + wr * 64 + m * 16 + fr;
        EPI_BJ { *(h8*)(dst + row * ldc + coff + bj * 128 + wc * 32 + fq * 8) = cvt8(acc[ai][bj][m][0], acc[ai][bj][m][1]); } } });
}

__device__ __forceinline__ void phase_plain(const hf* A, int lda, const hf* Wt, int K, hf* dst, int ldc, int nM, int nN) {
  gemm_stream([&](int i, GU& d) AINL -> bool { int pm, pn; if (!tile_order(i, nM, nN, pm, pn)) return false; set_gu(d, A, lda, Wt, K, K, pm * 256, pn * 256, 0); return true; },
    [&](EPI_ARGS) AINL {
      EPI_ROWS { const long row = d.brow + ai * 128 + wr * 64 + m * 16 + fr;
        EPI_BJ { *(h8*)(dst + row * ldc + d.bcol + bj * 128 + wc * 32 + fq * 8) = cvt8(acc[ai][bj][m][0], acc[ai][bj][m][1]); } } });
}

__device__ __forceinline__ void phase_s5_glu(KP p, int l) {
  const float* gb = p->in[18] + l * 512; const hf* y = p->s5tmp; hf* dst = p->su; const hf* glu = p->glu;
  gemm_stream([&](int i, GU& d) AINL -> bool { int pm, pn; if (!tile_order(i, 128, 2, pm, pn)) return false; set_gu(d, y, 512, glu, 512, 512, pm * 256, pn * 256, 0); return true; },
    [&](EPI_ARGS) AINL {
      EPI_ROWS { const long row = d.brow + ai * 128 + wr * 64 + m * 16 + fr;
        EPI_BJ { const int col = d.bcol + bj * 128 + wc * 32 + fq * 8;
          const h8 yy = *(const h8*)(y + row * 512 + col); const f4 b0 = *(const f4*)(gb + col), b1 = *(const f4*)(gb + col + 4); f4 v0 = acc[ai][bj][m][0], v1 = acc[ai][bj][m][1];
          _Pragma("unroll") for (int j = 0; j < 4; ++j) { v0[j] = (float)yy[j] * sigmoidf_(v0[j] + b0[j]); v1[j] = (float)yy[4 + j] * sigmoidf_(v1[j] + b1[j]); }
          *(h8*)(dst + row * 512 + col) = cvt8(v0, v1); } } });
}

__device__ __forceinline__ void phase_merge(KP p) {
  gemm_stream([&](int idx, GU& d) AINL -> bool {
      const int it = idx >> 3, s = idx & 7, i = s >> 1; int pm, pn; if (!tile_order(it, 128, 4, pm, pn)) return false;
      KP q = getp();
      if ((s & 1) == 0) set_gu(d, q->x16, 1024, q->wmix + (size_t)(3840 + i * 1024) * 1024, 1024, 1024, pm * 256, pn * 256, s);
      else { const hf* A = i == 0 ? q->swo : i == 1 ? q->su : i == 2 ? q->convout : q->dfo; const hf* W = i == 0 ? q->pswa : i == 1 ? q->ps5 : i == 2 ? q->pconv : q->pdiff;
        set_gu(d, A, 512, W, 512, 512, pm * 256, pn * 256, s); }
      return true; },
    [&](EPI_ARGS) AINL {
      const int s = d.aux; KP q = getp(); hf* gbuf = q->dk; hf* merged = q->cu;
      if ((s & 1) == 0) {
        EPI_ROWS { const long row = d.brow + ai * 128 + wr * 64 + m * 16 + fr;
          EPI_BJ { f4 v0 = acc[ai][bj][m][0], v1 = acc[ai][bj][m][1]; _Pragma("unroll") for (int j = 0; j < 4; ++j) { v0[j] = sigmoidf_(v0[j]); v1[j] = sigmoidf_(v1[j]); }
            *(h8*)(gbuf + row * 1024 + d.bcol + bj * 128 + wc * 32 + fq * 8) = cvt8(v0, v1); } }
      } else {
        EPI_ROWS { const long row = d.brow + ai * 128 + wr * 64 + m * 16 + fr;
          EPI_BJ { const long o = row * 1024 + d.bcol + bj * 128 + wc * 32 + fq * 8;
            const h8 g = *(const h8*)(gbuf + o); f4 v0 = acc[ai][bj][m][0], v1 = acc[ai][bj][m][1];
            _Pragma("unroll") for (int j = 0; j < 4; ++j) { v0[j] *= (float)g[j]; v1[j] *= (float)g[4 + j]; }
            if (s > 1) { const h8 mo = *(const h8*)(merged + o); _Pragma("unroll") for (int j = 0; j < 4; ++j) { v0[j] += (float)mo[j]; v1[j] += (float)mo[4 + j]; } }
            *(h8*)(merged + o) = cvt8(v0, v1); } }
      } });
}

__device__ __forceinline__ float wave_sum(float v) {
  for (int o = 32; o > 0; o >>= 1) v += __shfl_xor(v, o);
  return v;
}

__device__ __forceinline__ void ln_rows(const float* src, const float* g, const float* b, float* dst32, hf* dst16, int nrows) {
  const int wave = blockIdx.x * 8 + (tidx() >> 6), nw = gridDim.x * 8, lane = tidx() & 63;
  f4 gg[4], bb[4];
  for (int i = 0; i < 4; ++i) { gg[i] = *(const f4*)(g + i * 256 + lane * 4); bb[i] = *(const f4*)(b + i * 256 + lane * 4); }
  for (int r = wave; r < nrows; r += nw) {
    f4 v[4]; float s = 0.f;
    for (int i = 0; i < 4; ++i) { v[i] = *(const f4*)(src + (long)r * 1024 + i * 256 + lane * 4); s += (v[i][0] + v[i][1]) + (v[i][2] + v[i][3]); }
    const float mu = wave_sum(s) * (1.0f / 1024.0f);
    float q = 0.f;
    for (int i = 0; i < 4; ++i) for (int j = 0; j < 4; ++j) { const float d = v[i][j] - mu; q += d * d; }
    const float rs = rsqrtf(wave_sum(q) * (1.0f / 1024.0f) + 1e-5f);
    for (int i = 0; i < 4; ++i) { f4 o; for (int j = 0; j < 4; ++j) o[j] = (v[i][j] - mu) * rs * gg[i][j] + bb[i][j];
      if (dst32) *(f4*)(dst32 + (long)r * 1024 + i * 256 + lane * 4) = o;
      *(h4*)(dst16 + (long)r * 1024 + i * 256 + lane * 4) = cvt4(o); }
  }
}

__device__ __forceinline__ void ln_rows16(const hf* src, const float* g, const float* b, float* dst32, hf* dst16, int nrows) {
  const int wave = blockIdx.x * 8 + (tidx() >> 6), nw = gridDim.x * 8, lane = tidx() & 63;
  f4 gg[4], bb[4];
  for (int i = 0; i < 4; ++i) { gg[i] = *(const f4*)(g + i * 256 + lane * 4); bb[i] = *(const f4*)(b + i * 256 + lane * 4); }
  for (int r = wave; r < nrows; r += nw) {
    f4 v[4]; float s = 0.f;
    for (int i = 0; i < 4; ++i) { const h4 t = *(const h4*)(src + (long)r * 1024 + i * 256 + lane * 4); v[i][0] = (float)t[0]; v[i][1] = (float)t[1]; v[i][2] = (float)t[2]; v[i][3] = (float)t[3];
      s += (v[i][0] + v[i][1]) + (v[i][2] + v[i][3]); }
    const float mu = wave_sum(s) * (1.0f / 1024.0f);
    float q = 0.f;
    for (int i = 0; i < 4; ++i) for (int j = 0; j < 4; ++j) { const float d = v[i][j] - mu; q += d * d; }
    const float rs = rsqrtf(wave_sum(q) * (1.0f / 1024.0f) + 1e-5f);
    for (int i = 0; i < 4; ++i) { f4 o; for (int j = 0; j < 4; ++j) o[j] = (v[i][j] - mu) * rs * gg[i][j] + bb[i][j];
      if (dst32) *(f4*)(dst32 + (long)r * 1024 + i * 256 + lane * 4) = o;
      *(h4*)(dst16 + (long)r * 1024 + i * 256 + lane * 4) = cvt4(o); }
  }
}

__device__ __forceinline__ void conv_w_job(const float* __restrict__ src, int ld, int K, hf* __restrict__ dst, int NBk  , int mode, int coloff) {
  float* tile = (float*)smem;
  const int nkb = K / 64, total = NBk * nkb, tid = tidx();
  for (int u = blockIdx.x; u < total; u += gridDim.x) {
    const int nb = u / nkb, kb = u % nkb;
    int c0;
    if (mode == 0) c0 = coloff + nb * 64;
    else { const int j = nb >> 2, sub = nb & 3; c0 = (sub < 2) ? (j * 128 + sub * 64) : (FFN + j * 128 + (sub - 2) * 64); }
    __syncthreads();
    for (int h = 0; h < 2; ++h) { const int kk = (tid >> 4) + h * 32, c4 = tid & 15;
      const f4 v = *(const f4*)(src + (long)(kb * 64 + kk) * ld + c0 + c4 * 4);
      for (int j = 0; j < 4; ++j) tile[kk * 65 + c4 * 4 + j] = v[j]; }
    __syncthreads();
    { const int n = tid >> 3, k8 = tid & 7; h8 o;
      const int rho = n & 31, ii = rho & 15, ns = (n & 32) + 8 * (ii >> 2) + 4 * (rho >> 4) + (ii & 3);
      for (int j = 0; j < 8; ++j) o[j] = (hf)tile[(k8 * 8 + j) * 65 + ns];
      *(h8*)(dst + (long)(nb * 64 + n) * K + kb * 64 + k8 * 8) = o; }
  }
}

__device__ __forceinline__ void convert_ffn(KP p, const float* w_in, const float* w_out, hf* din, hf* dout) {
  conv_w_job(w_in, 2 * FFN, 1024, din, 88, 1, 0);
  conv_w_job(w_out, 1024, FFN, dout, 16, 0, 0);
}
__device__ __forceinline__ void convert_mix(KP p, int l) {
  conv_w_job(p->in[6] + (long)l * 1024 * 7936, 7936, 1024, p->wmix, 124, 0, 0);
  conv_w_job(p->in[8] + (long)l * 512 * 1024, 1024, 512, p->pswa, 16, 0, 0);
  conv_w_job(p->in[19] + (long)l * 512 * 1024, 1024, 512, p->ps5, 16, 0, 0);
  conv_w_job(p->in[24] + (long)l * 512 * 1024, 1024, 512, p->pconv, 16, 0, 0);
  conv_w_job(p->in[30] + (long)l * 512 * 1024, 1024, 512, p->pdiff, 16, 0, 0);
  conv_w_job(p->in[17] + (long)l * 512 * 512, 512, 512, p->glu, 8, 0, 0);
  conv_w_job(p->in[31] + (long)l * 1024 * 1024, 1024, 1024, p->wout, 16, 0, 0);
}
__device__ __forceinline__ void convert_cross(KP p, int l) {
  conv_w_job(p->in[36] + (long)l * 1024 * 512, 512, 1024, p->wq, 8, 0, 0);
  conv_w_job(p->in[38] + (long)l * 512 * 1024, 1024, 512, p->wo, 16, 0, 0);
}

__device__ __forceinline__ void phase_init(KP p) {
  { const long n4 = (long)NTOK * 1024 / 4; const f4* s = (const f4*)p->in[0]; h4* d = (h4*)p->x16;
    for (long i = (long)blockIdx.x * 512 + tidx(); i < n4; i += (long)gridDim.x * 512) d[i] = cvt4(s[i]); }
  ln_rows(p->in[1], p->in[34], p->in[35], nullptr, p->memn, 4096);
  convert_ffn(p, p->in[2], p->in[3], p->w1in, p->w1out);
  for (int l = 0; l < 4; ++l) conv_w_job(p->in[37] + (long)l * 1024 * 1024, 1024, 1024, p->wkv + (long)l * 1024 * 1024, 16, 0, 0);
}

__device__ __forceinline__ h4 trrd(const hf* q) { return __builtin_bit_cast(h4, __builtin_amdgcn_ds_read_tr16_b64_v4i16((__attribute__((address_space(3))) s4v*)q)); }

template <int DK, int DV, int KW, bool ALIBI, int MASK>
__device__ __forceinline__ void attn_core(const hf* __restrict__ Kg, long kstride, const hf* __restrict__ Vg, long vstride, int T0, int T1,
                                          const hf* __restrict__ Qw, long qstride, int kcol, int q0, float c1, float c2,
                                          f4 (&O)[2][DV / 16], float (&m)[2], float (&l)[2]) {
  constexpr int KSTR = KW + 8, VSTR = DV + 8, KCH = KW / 8, VCH = DV / 8, NKL = 64 * KCH / 512, NVL = 64 * VCH / 512;
  hf* Ks = (hf*)smem; hf* Vs = Ks + 64 * KSTR;
  const int tid = tidx(), lane = tid & 63, fr = lane & 15, fq = lane >> 4;
  h8 qf[2][DK / 32];
#pragma unroll
  for (int qs = 0; qs < 2; ++qs)
#pragma unroll
    for (int ks = 0; ks < DK / 32; ++ks) qf[qs][ks] = *(const h8*)(Qw + (long)(qs * 16 + fr) * qstride + ks * 32 + fq * 8);
  h8 kreg[NKL], vreg[NVL];
#pragma unroll
  for (int i = 0; i < NKL; ++i) { const int idx = tid + i * 512, r = idx / KCH, c = idx % KCH; kreg[i] = *(const h8*)(Kg + (long)(T0 * 64 + r) * kstride + c * 8); }
#pragma unroll
  for (int i = 0; i < NVL; ++i) { const int idx = tid + i * 512, r = idx / VCH, c = idx % VCH; vreg[i] = *(const h8*)(Vg + (long)(T0 * 64 + r) * vstride + c * 8); }
#pragma unroll 1
  for (int T = T0; T < T1; ++T) {
    __syncthreads();
#pragma unroll
    for (int i = 0; i < NKL; ++i) { const int idx = tid + i * 512, r = idx / KCH, c = idx % KCH; *(h8*)(Ks + r * KSTR + c * 8) = kreg[i]; }
#pragma unroll
    for (int i = 0; i < NVL; ++i) { const int idx = tid + i * 512, r = idx / VCH, c = idx % VCH; *(h8*)(Vs + r * VSTR + c * 8) = vreg[i]; }
    __syncthreads();
    if (T + 1 < T1) {
#pragma unroll
      for (int i = 0; i < NKL; ++i) { const int idx = tid + i * 512, r = idx / KCH, c = idx % KCH; kreg[i] = *(const h8*)(Kg + (long)((T + 1) * 64 + r) * kstride + c * 8); }
#pragma unroll
      for (int i = 0; i < NVL; ++i) { const int idx = tid + i * 512, r = idx / VCH, c = idx % VCH; vreg[i] = *(const h8*)(Vg + (long)((T + 1) * 64 + r) * vstride + c * 8); }
    }
    bool rel = true;
    if (MASK >= 1) rel = (T * 64 <= q0 + 31);
    if (MASK == 2) rel = rel && (T * 64 + 63 >= q0 - 127);
    if (rel) {
      f4 S[2][4];
#pragma unroll
      for (int kt = 0; kt < 4; ++kt) {
#pragma unroll
        for (int qs = 0; qs < 2; ++qs) S[qs][kt] = (f4){0.f, 0.f, 0.f, 0.f};
#pragma unroll
        for (int ks = 0; ks < DK / 32; ++ks) {
          const h8 kf = *(const h8*)(Ks + (kt * 16 + fr) * KSTR + kcol + ks * 32 + fq * 8);
#pragma unroll
          for (int qs = 0; qs < 2; ++qs) S[qs][kt] = __builtin_amdgcn_mfma_f32_16x16x32_f16(kf, qf[qs][ks], S[qs][kt], 0, 0, 0);
        }
      }
      h8 pf[2][2];
#pragma unroll
      for (int qs = 0; qs < 2; ++qs) {
        const int qp = q0 + qs * 16 + fr;
        float mx = m[qs];
        const float abase = ALIBI ? c2 * (float)(T * 64 + fq * 4 - qp) : 0.f;
        const bool need_mask = (MASK == 2) || (MASK == 1 && (T * 64 + 63 > q0));
        if (need_mask) {
#pragma unroll
          for (int kt = 0; kt < 4; ++kt)
#pragma unroll
            for (int jj = 0; jj < 4; ++jj) {
              const int kp = T * 64 + kt * 16 + fq * 4 + jj;
              float s = fmaf(S[qs][kt][jj], c1, ALIBI ? fmaf(c2, (float)(kt * 16 + jj), abase) : 0.f);
              if (MASK == 1) s = (kp <= qp) ? s : -1e30f;
              if (MASK == 2) s = (kp <= qp && qp - kp < 128) ? s : -1e30f;
              S[qs][kt][jj] = s; mx = fmaxf(mx, s);
            }
        } else {
#pragma unroll
          for (int kt = 0; kt < 4; ++kt)
#pragma unroll
            for (int jj = 0; jj < 4; ++jj) {
              const float s = fmaf(S[qs][kt][jj], c1, ALIBI ? fmaf(c2, (float)(kt * 16 + jj), abase) : 0.f);
              S[qs][kt][jj] = s; mx = fmaxf(mx, s);
            }
        }
        mx = fmaxf(mx, __shfl_xor(mx, 16)); mx = fmaxf(mx, __shfl_xor(mx, 32));
        const float alpha = __builtin_amdgcn_exp2f(m[qs] - mx); m[qs] = mx;
        float ps = 0.f;
#pragma unroll
        for (int kt = 0; kt < 4; ++kt)
#pragma unroll
          for (int jj = 0; jj < 4; ++jj) { const float pv = __builtin_amdgcn_exp2f(S[qs][kt][jj] - mx); ps += pv; S[qs][kt][jj] = pv; }
        l[qs] = l[qs] * alpha + ps;
#pragma unroll
        for (int et = 0; et < DV / 16; ++et) O[qs][et] *= alpha;
#pragma unroll
        for (int pr = 0; pr < 2; ++pr)
#pragma unroll
          for (int jj = 0; jj < 4; ++jj) { pf[qs][pr][jj] = (hf)S[qs][2 * pr][jj]; pf[qs][pr][4 + jj] = (hf)S[qs][2 * pr + 1][jj]; }
      }
#pragma unroll
      for (int pr = 0; pr < 2; ++pr)
#pragma unroll
        for (int et = 0; et < DV / 16; ++et) {
          const h4 v0 = trrd(Vs + (pr * 32 + fq * 4 + (fr >> 2)) * VSTR + et * 16 + (fr & 3) * 4);
          const h4 v1 = trrd(Vs + (pr * 32 + 16 + fq * 4 + (fr >> 2)) * VSTR + et * 16 + (fr & 3) * 4);
          h8 vf; vf[0] = v0[0]; vf[1] = v0[1]; vf[2] = v0[2]; vf[3] = v0[3]; vf[4] = v1[0]; vf[5] = v1[1]; vf[6] = v1[2]; vf[7] = v1[3];
#pragma unroll
          for (int qs = 0; qs < 2; ++qs) O[qs][et] = __builtin_amdgcn_mfma_f32_16x16x32_f16(vf, pf[qs][pr], O[qs][et], 0, 0, 0);
        }
    }
  }
}

__device__ __forceinline__ void swa_unit(KP p, int l, int u) {
  const int hp = u & 1, n = (u >> 1) & 15, g = (u >> 5) & 1, b = u >> 6;
  const int w = tidx() >> 6, lane = tidx() & 63, fr = lane & 15, fq = lane >> 4;
  const int hq = g * 4 + hp * 2 + (w >> 2), q0 = n * 128 + (w & 3) * 32;
  const hf* Kg = p->akv + (long)b * SEQ * 256 + g * 64; const hf* Vg = Kg + 128;
  hf* Qw = p->aq + ((long)b * SEQ + q0) * 512 + hq * 64;
  hf* Ow = p->swo + ((long)b * SEQ + q0) * 512 + hq * 64;
  const float slope = exp2f(-(float)(hq + 1));
  f4 O[2][4]; float m[2], ls[2];
  const float sink = p->in[7][l * 8 + hq] * LOG2E;
  for (int qs = 0; qs < 2; ++qs) { m[qs] = sink; ls[qs] = (fq == 0) ? 1.f : 0.f; for (int et = 0; et < 4; ++et) O[qs][et] = (f4){0.f, 0.f, 0.f, 0.f}; }
  const int T0 = (2 * n - 2) < 0 ? 0 : (2 * n - 2), T1 = 2 * n + 2;
  attn_core<64, 64, 64, true, 2>(Kg, 256, Vg, 256, T0, T1, Qw, 512, 0, q0, 0.125f * LOG2E, slope * LOG2E, O, m, ls);
  for (int qs = 0; qs < 2; ++qs) {
    float lt = ls[qs]; lt += __shfl_xor(lt, 16); lt += __shfl_xor(lt, 32);
    const float inv = 1.0f / lt;
    for (int et = 0; et < 4; ++et) *(h4*)(Ow + (long)(qs * 16 + fr) * 512 + et * 16 + fq * 4) = cvt4(O[qs][et] * inv);
  }
}

__device__ __forceinline__ void diff_unit(KP p, int l, int u) {
  const int n = 15 - (u >> 6), h = u & 3, b = (u >> 2) & 15;
  const int w = tidx() >> 6, lane = tidx() & 63, fr = lane & 15, fq = lane >> 4;
  const int comp = w & 1, q0 = n * 128 + (w >> 1) * 32;
  const hf* Kg = p->dk + (long)b * SEQ * 512 + h * 128; const hf* Vg = p->dv + (long)b * SEQ * 512 + h * 128;
  hf* Qrow = p->dq + ((long)b * SEQ + q0) * 512 + h * 128;
  hf* Orow = p->dfo + ((long)b * SEQ + q0) * 512 + h * 128;
  const float slope = exp2f(-2.0f * (float)(h + 1));
  const float lambda_init = 0.8f - 0.6f * expf(-0.3f * (float)l);
  float lam;
  { const float a = p->in[25][l * 64 + lane] * p->in[26][l * 64 + lane], c = p->in[27][l * 64 + lane] * p->in[28][l * 64 + lane];
    lam = expf(wave_sum(a)) - expf(wave_sum(c)) + lambda_init; }
  f4 O[2][8]; float m[2], ls[2];
  for (int qs = 0; qs < 2; ++qs) { m[qs] = -1e30f; ls[qs] = 0.f; for (int et = 0; et < 8; ++et) O[qs][et] = (f4){0.f, 0.f, 0.f, 0.f}; }
  attn_core<64, 128, 128, true, 1>(Kg, 512, Vg, 512, 0, 2 * n + 2, Qrow + comp * 64, 512, comp * 64, q0, 0.125f * LOG2E, slope * LOG2E, O, m, ls);
  float inv[2];
  for (int qs = 0; qs < 2; ++qs) { float lt = ls[qs]; lt += __shfl_xor(lt, 16); lt += __shfl_xor(lt, 32); inv[qs] = 1.0f / lt; }
  __syncthreads();
  float* XS = (float*)smem + (w >> 1) * 4096;
  if (comp == 1) {
    for (int qs = 0; qs < 2; ++qs) for (int et = 0; et < 8; ++et) for (int jj = 0; jj < 4; ++jj) XS[((qs * 8 + et) * 4 + jj) * 64 + lane] = O[qs][et][jj] * inv[qs];
  }
  __syncthreads();
  if (comp == 0) {
    const float* ng = p->in[29] + l * 128;
    for (int qs = 0; qs < 2; ++qs) {
      float ss = 0.f;
      for (int et = 0; et < 8; ++et) for (int jj = 0; jj < 4; ++jj) { const float v = O[qs][et][jj] * inv[qs] - lam * XS[((qs * 8 + et) * 4 + jj) * 64 + lane]; O[qs][et][jj] = v; ss += v * v; }
      ss += __shfl_xor(ss, 16); ss += __shfl_xor(ss, 32);
      const float r = rsqrtf(ss * (1.0f / 128.0f) + 1e-5f) * (1.0f - lambda_init);
      for (int et = 0; et < 8; ++et) { const f4 g4 = *(const f4*)(ng + et * 16 + fq * 4); f4 v = O[qs][et];
        for (int jj = 0; jj < 4; ++jj) v[jj] = v[jj] * r * g4[jj];
        *(h4*)(Orow + (long)(qs * 16 + fr) * 512 + et * 16 + fq * 4) = cvt4(v); }
    }
  }
}

__device__ __forceinline__ void cross_unit(KP p, int l, int u) {
  const int qb = u & 7, h = (u >> 3) & 3, b = u >> 5;
  const int w = tidx() >> 6, lane = tidx() & 63, fr = lane & 15, fq = lane >> 4;
  const int q0 = qb * 256 + w * 32;
  const hf* Kg = p->kvc + (long)l * 4096 * 1024 + (long)b * 256 * 1024 + h * 128; const hf* Vg = Kg + 512;
  const hf* Qw = p->aq + ((long)b * SEQ + q0) * 512 + h * 128;
  hf* Ow = p->dq + ((long)b * SEQ + q0) * 512 + h * 128;
  f4 O[2][8]; float m[2], ls[2];
  for (int qs = 0; qs < 2; ++qs) { m[qs] = -1e30f; ls[qs] = 0.f; for (int et = 0; et < 8; ++et) O[qs][et] = (f4){0.f, 0.f, 0.f, 0.f}; }
  attn_core<128, 128, 128, false, 0>(Kg, 1024, Vg, 1024, 0, 4, Qw, 512, 0, q0, 0.08838834764831845f * LOG2E, 0.f, O, m, ls);
  for (int qs = 0; qs < 2; ++qs) {
    float lt = ls[qs]; lt += __shfl_xor(lt, 16); lt += __shfl_xor(lt, 32);
    const float inv = 1.0f / lt;
    for (int et = 0; et < 8; ++et) *(h4*)(Ow + (long)(qs * 16 + fr) * 512 + et * 16 + fq * 4) = cvt4(O[qs][et] * inv);
  }
}

__device__ __forceinline__ void s5_unit(KP p, int l, int u) {
  const int b = u >> 2, w = tidx() >> 6, g = (u & 3) * 8 + w, lane = tidx() & 63, fr = lane & 15, fq = lane >> 4;
  float* BuS = (float*)(smem + w * 12800);
  float* Yt = BuS + 16 * 132;
  const int lg = l * 32 + g;
  const float step = expf(p->in[11][lg]);
  float abr, abi;
  { const float ar = p->in[9][lg * 64 + lane], ai = p->in[10][lg * 64 + lane]; const float mag = expf(ar * step); abr = mag * cosf(ai * step); abi = mag * sinf(ai * step); }
  h8 bfr[8];
#pragma unroll
  for (int nt = 0; nt < 8; ++nt) {
    const int pp = (nt & 3) * 16 + fr;
    const float ar = p->in[9][lg * 64 + pp], ai = p->in[10][lg * 64 + pp]; const float mag = expf(ar * step);
    const float nr = mag * cosf(ai * step) - 1.0f, ni = mag * sinf(ai * step), den = ar * ar + ai * ai;
    const float cr = (nr * ar + ni * ai) / den, ci = (ni * ar - nr * ai) / den;
    const float* brp = p->in[12] + ((long)lg * 64 + pp) * 16 + (fq & 1) * 8; const float* bip = p->in[13] + ((long)lg * 64 + pp) * 16 + (fq & 1) * 8;
#pragma unroll
    for (int s = 0; s < 8; ++s) { const float v = (nt < 4) ? (cr * brp[s] - ci * bip[s]) : (cr * bip[s] + ci * brp[s]); bfr[nt][s] = (fq < 2) ? (hf)v : (hf)0.0f; }
  }
  h8 cfr[4];
#pragma unroll
  for (int ks = 0; ks < 4; ++ks) {
    const float* src = (ks < 2 ? p->in[14] : p->in[15]) + ((long)lg * 16 + fr) * 64 + (ks & 1) * 32 + fq * 8;
    const float sg = ks < 2 ? 1.0f : -1.0f;
#pragma unroll
    for (int j = 0; j < 8; ++j) cfr[ks][j] = (hf)(sg * src[j]);
  }
  h8 dfr;
  { const float dd = p->in[16][l * 512 + g * 16 + fr];
#pragma unroll
    for (int s = 0; s < 8; ++s) dfr[s] = (fq < 2 && (fq & 1) * 8 + s == fr) ? (hf)dd : (hf)0.0f; }
  float xr = 0.f, xi = 0.f;
  const hf* up = p->su + (long)b * SEQ * 512 + g * 16 + (fq & 1) * 8;
  hf* yp = p->s5tmp + (long)b * SEQ * 512 + g * 16;
  h8 un = *(const h8*)(up + (long)fr * 512);
#pragma unroll 1
  for (int ch = 0; ch < 128; ++ch) {
    h8 uf = un;
    if (fq >= 2) { for (int s = 0; s < 8; ++s) uf[s] = (hf)0.0f; }
    if (ch < 127) un = *(const h8*)(up + (long)((ch + 1) * 16 + fr) * 512);
#pragma unroll
    for (int nt = 0; nt < 8; ++nt) {
      const f4 d = __builtin_amdgcn_mfma_f32_16x16x32_f16(uf, bfr[nt], (f4){0.f, 0.f, 0.f, 0.f}, 0, 0, 0);
#pragma unroll
      for (int jj = 0; jj < 4; ++jj) BuS[(fq * 4 + jj) * 132 + nt * 16 + fr] = d[jj];
    }
    __syncthreads();
    float br_[16], bi_[16];
#pragma unroll
    for (int t = 0; t < 16; ++t) { br_[t] = BuS[t * 132 + lane]; bi_[t] = BuS[t * 132 + 64 + lane]; }
#pragma unroll
    for (int t = 0; t < 16; ++t) {
      const float nxr = abr * xr - abi * xi + br_[t], nxi = abr * xi + abi * xr + bi_[t]; xr = nxr; xi = nxi;
      BuS[t * 132 + lane] = xr; BuS[t * 132 + 64 + lane] = xi;
    }
    __syncthreads();
    f4 y = (f4){0.f, 0.f, 0.f, 0.f};
#pragma unroll
    for (int ks = 0; ks < 4; ++ks) {
      const f4 xa = *(const f4*)(BuS + fr * 132 + ks * 32 + fq * 8), xb = *(const f4*)(BuS + fr * 132 + ks * 32 + fq * 8 + 4);
      h8 xf; xf[0] = (hf)xa[0]; xf[1] = (hf)xa[1]; xf[2] = (hf)xa[2]; xf[3] = (hf)xa[3]; xf[4] = (hf)xb[0]; xf[5] = (hf)xb[1]; xf[6] = (hf)xb[2]; xf[7] = (hf)xb[3];
      y = __builtin_amdgcn_mfma_f32_16x16x32_f16(xf, cfr[ks], y, 0, 0, 0);
    }
    y = __builtin_amdgcn_mfma_f32_16x16x32_f16(uf, dfr, y, 0, 0, 0);
#pragma unroll
    for (int jj = 0; jj < 4; ++jj) {
      const float v = y[jj], z = 0.7978845608028654f * (v + 0.044715f * v * v * v);
      const float th = 1.0f - 2.0f * __builtin_amdgcn_rcpf(__builtin_amdgcn_exp2f(2.8853900817779268f * z) + 1.0f);
      Yt[(fq * 4 + jj) * 20 + fr] = 0.5f * v * (1.0f + th);
    }
    __syncthreads();
    { const int t = lane >> 2, c4 = (lane & 3) * 4; const f4 v = *(const f4*)(Yt + t * 20 + c4);
      *(h4*)(yp + (long)(ch * 16 + t) * 512 + c4) = cvt4(v); }
  }
}

__device__ __forceinline__ void conv_unit(KP p, int l, int u) {
  const int b = u >> 5, t0 = (u & 31) * 64, tid = tidx(), w = tid >> 6, lane = tid & 63;
  hf* G = (hf*)smem;
  hf* Wc = (hf*)(smem + 96256);
  for (int idx = tid; idx < 94 * 64; idx += 512) {
    const int r = idx >> 6, c8 = idx & 63, t = t0 - 30 + r; h8 o;
    if (t >= 0) { const hf* src = p->cu + ((long)b * SEQ + t) * 1024 + c8 * 8; const h8 v = *(const h8*)src, gt = *(const h8*)(src + 512);
      for (int j = 0; j < 8; ++j) o[j] = (hf)((float)v[j] * sigmoidf_((float)gt[j])); }
    else { for (int j = 0; j < 8; ++j) o[j] = (hf)0.0f; }
    *(h8*)(G + r * 512 + c8 * 8) = o;
  }
  { const float* cw = p->in[20] + (long)l * 31 * 512; for (int idx = tid; idx < 31 * 512; idx += 512) Wc[idx] = (hf)cw[idx]; }
  __syncthreads();
  const float* cb = p->in[21] + l * 512 + lane * 8; const f4 b0 = *(const f4*)cb, b1 = *(const f4*)(cb + 4);
  const float* lg = p->in[22] + l * 512 + lane * 8; const float* lb = p->in[23] + l * 512 + lane * 8;
  const f4 g0 = *(const f4*)lg, g1 = *(const f4*)(lg + 4), c0 = *(const f4*)lb, c1 = *(const f4*)(lb + 4);
#pragma unroll 1
  for (int jp = 0; jp < 4; ++jp) {
    float a0[8], a1[8];
#pragma unroll
    for (int c = 0; c < 8; ++c) { a0[c] = c < 4 ? b0[c & 3] : b1[c & 3]; a1[c] = a0[c]; }
    const hf* gp = G + (w * 8 + jp * 2) * 512 + lane * 8;
    h8 wprev;
#pragma unroll
    for (int c = 0; c < 8; ++c) wprev[c] = (hf)0.0f;
#pragma unroll 8
    for (int k = 0; k < 32; ++k) {
      const h8 gv = *(const h8*)(gp + k * 512);
      h8 wv;
      if (k < 31) wv = *(const h8*)(Wc + k * 512 + lane * 8); else { for (int c = 0; c < 8; ++c) wv[c] = (hf)0.0f; }
#pragma unroll
      for (int c = 0; c < 8; ++c) { a0[c] += (float)gv[c] * (float)wv[c]; a1[c] += (float)gv[c] * (float)wprev[c]; }
      wprev = wv;
    }
#pragma unroll
    for (int jj = 0; jj < 2; ++jj) {
      float s = 0.f;
#pragma unroll
      for (int c = 0; c < 8; ++c) s += jj ? a1[c] : a0[c];
      const float mu = wave_sum(s) * (1.0f / 512.0f);
      float q = 0.f;
#pragma unroll
      for (int c = 0; c < 8; ++c) { const float d = (jj ? a1[c] : a0[c]) - mu; q += d * d; }
      const float rs = rsqrtf(wave_sum(q) * (1.0f / 512.0f) + 1e-5f);
      h8 o;
#pragma unroll
      for (int c = 0; c < 8; ++c) { const float gg = c < 4 ? g0[c & 3] : g1[c & 3], bb = c < 4 ? c0[c & 3] : c1[c & 3];
        const float v = ((jj ? a1[c] : a0[c]) - mu) * rs * gg + bb; o[c] = (hf)(v * sigmoidf_(v)); }
      *(h8*)(p->convout + ((long)b * SEQ + t0 + w * 8 + jp * 2 + jj) * 512 + lane * 8) = o;
    }
  }
}

__device__ __forceinline__ void phase_mixers(KP p, int l, int cidx) {
  volatile int* ctl = (volatile int*)(smem + CTL_OFF);
  const int NS5 = 64, NDIFF = 1024, NSWA = 1024, NCONV = 512, TOTAL = NS5 + NDIFF + NSWA + NCONV;
  for (;;) {
    __syncthreads();
    if (tidx() == 0) *ctl = (int)atomicAdd(p->counters + cidx, 1u);
    __syncthreads();
    const int it = *ctl;
    if (it >= TOTAL) break;
    if (it < NS5) s5_unit(p, l, it);
    else if (it < NS5 + NDIFF) diff_unit(p, l, it - NS5);
    else if (it < NS5 + NDIFF + NSWA) swa_unit(p, l, it - NS5 - NDIFF);
    else conv_unit(p, l, it - NS5 - NDIFF - NSWA);
  }
}
__device__ __forceinline__ void phase_cross_attn(KP p, int l) {
  for (int u = blockIdx.x; u < 512; u += gridDim.x) { __syncthreads(); cross_unit(p, l, u); }
}

__global__ void __launch_bounds__(512) fwd_megakernel(Params pv) {
  cg::grid_group grid = cg::this_grid();
  if (tidx() == 0) { const unsigned long long kp = (unsigned long long)__builtin_amdgcn_kernarg_segment_ptr();
    volatile __attribute__((address_space(3))) unsigned* s = (volatile __attribute__((address_space(3))) unsigned*)(smem + 136 * 1024 + 16);
    s[0] = (unsigned)kp; s[1] = (unsigned)(kp >> 32); s[4] = 0u; s[5] = 0u; }
  __syncthreads();
  if (tidx() == 0) (void)xb_add(&getp()->counters[XB_XCNT(xb_xcc_id())], 1u);
  phase_init(getp());
  grid.sync();
#pragma unroll 1
  for (int j = 0; j < 8; ++j) {
    const int l = j >> 1, second = j & 1;
    phase_ffn_a(getp(), getp()->w1in, j == 0);
    gbar();
    phase_resid(getp(), getp()->aq, FFN, getp()->w1out, FFN, 0.5f);
    gbar();
    ln_rows16(getp()->s5tmp, getp()->in[second ? 43 : 4] + l * 1024, getp()->in[second ? 44 : 5] + l * 1024, j == 7 ? getp()->out : (float*)nullptr, getp()->x16, NTOK);
    if (!second) convert_mix(getp(), l);
    else if (l < 3) convert_ffn(getp(), getp()->in[2] + (long)(l + 1) * 1024 * 2 * FFN, getp()->in[3] + (long)(l + 1) * FFN * 1024, getp()->w1in, getp()->w1out);
    gbar();
    if (!second) {
      phase_mix_a(getp());
      gbar();
      phase_mixers(getp(), l, l);
      gbar();
      phase_s5_glu(getp(), l);
      gbar();
      phase_merge(getp());
      gbar();
      phase_resid(getp(), getp()->cu, 1024, getp()->wout, 1024, 1.0f);
      gbar();
      ln_rows16(getp()->s5tmp, getp()->in[32] + l * 1024, getp()->in[33] + l * 1024, (float*)nullptr, getp()->x16, NTOK);
      convert_cross(getp(), l);
      gbar();
      phase_plain(getp()->x16, 1024, getp()->wq, 1024, getp()->aq, 512, 128, 2);
      gbar();
      phase_cross_attn(getp(), l);
      gbar();
      phase_resid(getp(), getp()->dq, 512, getp()->wo, 512, 1.0f);
      gbar();
      ln_rows16(getp()->s5tmp, getp()->in[39] + l * 1024, getp()->in[40] + l * 1024, (float*)nullptr, getp()->x16, NTOK);
      convert_ffn(getp(), getp()->in[41] + (long)l * 1024 * 2 * FFN, getp()->in[42] + (long)l * FFN * 1024, getp()->w1in, getp()->w1out);
      gbar();
    }
  }
}

extern "C" void kernel_launch(void* const* d_in, const int* in_sizes, int n_in, void* d_out, int out_size, void* d_ws, size_t ws_size, hipStream_t stream) {
  Params p; memset(&p, 0, sizeof(p));
  for (int i = 0; i < 45; ++i) p.in[i] = (const float*)d_in[i];
  p.out = (float*)d_out;
  char* base = (char*)d_ws; size_t off = 0;
  auto carve = [&](size_t halves) { hf* r = (hf*)(base + off); off += (halves * 2 + 255) & ~(size_t)255; return r; };
  p.counters = (unsigned*)base; off = 16384;
  p.x16 = carve((size_t)NTOK * 1024);
  p.w1in = carve((size_t)5632 * 1024); p.w1out = carve((size_t)1024 * FFN);
  p.wmix = carve((size_t)7936 * 1024);
  p.pswa = carve(1024 * 512); p.ps5 = carve(1024 * 512); p.pconv = carve(1024 * 512); p.pdiff = carve(1024 * 512);
  p.glu = carve(512 * 512); p.wout = carve(1024 * 1024); p.wq = carve(512 * 1024); p.wo = carve(1024 * 512);
  p.wkv = carve((size_t)4 * 1024 * 1024); p.kvc = carve((size_t)4 * 4096 * 1024); p.memn = carve((size_t)4096 * 1024);
  p.aq = carve((size_t)NTOK * 512); p.akv = carve((size_t)NTOK * 256); p.dq = carve((size_t)NTOK * 512);
  p.dk = carve((size_t)NTOK * 512); p.dv = carve((size_t)NTOK * 512); p.su = carve((size_t)NTOK * 512); p.cu = carve((size_t)NTOK * 1024);
  p.s5tmp = carve((size_t)NTOK * 512); p.convout = carve((size_t)NTOK * 512);
  p.swo = carve((size_t)NTOK * 512); p.dfo = carve((size_t)NTOK * 512);
  static int grid_blocks = 0;
  if (!grid_blocks) {
    hipFuncSetAttribute((const void*)fwd_megakernel, hipFuncAttributeMaxDynamicSharedMemorySize, LDS_BYTES);
    int dev = 0, cus = 0, per_cu = 0;
    hipGetDevice(&dev);
    hipDeviceGetAttribute(&cus, hipDeviceAttributeMultiprocessorCount, dev);
    hipOccupancyMaxActiveBlocksPerMultiprocessor(&per_cu, fwd_megakernel, 512, LDS_BYTES);
    if (per_cu > 1) per_cu = 1;
    grid_blocks = cus * per_cu;
    if (grid_blocks <= 0) grid_blocks = 256;
  }
  (void)hipMemsetAsync(d_ws, 0, 16384, stream);
  void* args[] = {&p};
  hipError_t e = hipLaunchCooperativeKernel((const void*)fwd_megakernel, dim3(grid_blocks), dim3(512), args, LDS_BYTES, stream);
  if (e != hipSuccess) fprintf(stderr, "cooperative launch failed: %s (grid %d)\n", hipGetErrorString(e), grid_blocks);
}
```

```cpp
#include <hip/hip_runtime.h>
#include <hip/hip_cooperative_groups.h>
#include <cstdio>
#include <cstring>
namespace cg = cooperative_groups;

typedef _Float16 hf;
typedef _Float16 h8 __attribute__((ext_vector_type(8)));
typedef _Float16 h4 __attribute__((ext_vector_type(4)));
typedef short s4v __attribute__((ext_vector_type(4)));
typedef float f4 __attribute__((ext_vector_type(4)));

constexpr int NTOK = 32768, SEQ = 2048, FFN = 2816;
constexpr int LDS_BYTES = 140 * 1024;
constexpr int CTL_OFF = 136 * 1024;
constexpr float LOG2E = 1.4426950408889634f;
constexpr float DN_ALPHA = 1.681792830507429f;

struct Params {
  const float* in[45];
  float* out;
  hf *x16, *w1in, *w1out, *wbin, *wbout, *wmix, *pswa, *ps5, *pconv, *pdiff, *glu, *wout, *wq, *wo, *wkv, *kvc, *memn;
  hf *aq, *akv, *dq, *dk, *dv, *su, *cu, *s5tmp, *convout, *swo, *dfo;
  unsigned long long* xstat;
  unsigned* counters;
  unsigned pad_;
  unsigned pad2_;
};

extern __shared__ __attribute__((aligned(16))) unsigned char smem[];
__device__ __forceinline__ int tidx() { int t = __builtin_amdgcn_workitem_id_x(); asm volatile("" : "+v"(t)); return t; }
typedef const __attribute__((address_space(4))) Params* KP;
__device__ __forceinline__ KP getp() {
  volatile __attribute__((address_space(3))) unsigned* s = (volatile __attribute__((address_space(3))) unsigned*)(smem + 136 * 1024 + 16);
  const unsigned lo = __builtin_amdgcn_readfirstlane(s[0]), hi = __builtin_amdgcn_readfirstlane(s[1]);
  unsigned long long v = ((unsigned long long)hi << 32) | lo;
  asm volatile("" : "+s"(v));
  return (KP)v;
}

#define XB_TMO      128
#define XB_XCNT(j)  (256  + 64 * (j))
#define XB_XSUB(j)  (1280 + 64 * (j))
#define XB_XGEN(j)  (2304 + 64 * (j))
#define XB_TOP      3328
#define XB_TOPGEN   3392
#define XB_SPIN_CAP (1u << 20)
__device__ __forceinline__ unsigned xb_ld(unsigned* p)              { return __hip_atomic_load(p, __ATOMIC_RELAXED, __HIP_MEMORY_SCOPE_AGENT); }
__device__ __forceinline__ unsigned xb_add(unsigned* p, unsigned v) { return __hip_atomic_fetch_add(p, v, __ATOMIC_RELAXED, __HIP_MEMORY_SCOPE_AGENT); }
__device__ __forceinline__ unsigned xb_xcc_id() { return (unsigned)__builtin_amdgcn_s_getreg((3 << 11) | 20) & 0xFu; }
#define XB_SPIN(cond, bar) do { unsigned _sp = 0; while (cond) { __builtin_amdgcn_s_sleep(1); \
    if ((++_sp & 255u) == 0u) { if (xb_ld(&(bar)[XB_TMO])) break; if (_sp > XB_SPIN_CAP) { atomicAdd(&(bar)[XB_TMO], 1u); break; } } } } while (0)
__device__ __forceinline__ void xcd_barrier_complete(unsigned* bar, unsigned x, unsigned& nloc, unsigned& nx) {
  const unsigned G = gridDim.x;
  unsigned sum, cnt, mine, sp = 0u;
  for (;;) {
    sum = 0u; cnt = 0u; mine = 0u;
#pragma unroll
    for (unsigned j = 0; j < 16; ++j) { const unsigned c = xb_ld(&bar[XB_XCNT(j)]); sum += c; cnt += (c > 0u) ? 1u : 0u; mine = (j == x) ? c : mine; }
    if (sum == G) break;
    __builtin_amdgcn_s_sleep(1);
    if ((++sp & 255u) == 0u) { if (xb_ld(&bar[XB_TMO])) break; if (sp > XB_SPIN_CAP) { atomicAdd(&bar[XB_TMO], 1u); break; } }
  }
  nloc = mine > 0u ? mine : 1u; nx = cnt > 0u ? cnt : 1u;
}
__device__ __forceinline__ void gbar() {
  asm volatile("s_waitcnt vmcnt(0)" ::: "memory");
  __syncthreads();
  if (tidx() == 0) {
    unsigned* bar = getp()->counters;
    volatile __attribute__((address_space(3))) unsigned* st = (volatile __attribute__((address_space(3))) unsigned*)(smem + 136 * 1024 + 32);
    const unsigned x = xb_xcc_id();
    __builtin_amdgcn_s_waitcnt(0);
    unsigned nloc = st[0], nx = st[1];
    if (nloc == 0u) { xcd_barrier_complete(bar, x, nloc, nx); st[0] = nloc; st[1] = nx; }
    const unsigned old = xb_add(&bar[XB_XSUB(x)], 1u);
    const unsigned gen = old / nloc;
    if (old + 1u == (gen + 1u) * nloc) {
      __builtin_amdgcn_fence(__ATOMIC_RELEASE, "agent");
      asm volatile("s_waitcnt vmcnt(0)" ::: "memory");
      const unsigned og = xb_add(&bar[XB_TOP], 1u);
      const unsigned tg = og / nx;
      if (og + 1u == (tg + 1u) * nx) xb_add(&bar[XB_TOPGEN], 1u);
      else XB_SPIN(xb_ld(&bar[XB_TOPGEN]) == tg, bar);
      __builtin_amdgcn_fence(__ATOMIC_ACQUIRE, "agent");
      xb_add(&bar[XB_XGEN(x)], 1u);
      asm volatile("s_waitcnt vmcnt(0)" ::: "memory");
    } else {
      XB_SPIN(xb_ld(&bar[XB_XGEN(x)]) == gen, bar);
      __builtin_amdgcn_fence(__ATOMIC_ACQUIRE, "agent");
      asm volatile("s_waitcnt vmcnt(0)" ::: "memory");
    }
  }
  __syncthreads();
}

constexpr int BM = 256, BK = 64, HALFT = 128, HT = HALFT * BK;
__device__ __forceinline__ int lds_byte(int r, int c) {
  int st = (r >> 4) * 2 + (c >> 5), rr = r & 15, cc = c & 31, ob = rr * 64 + cc * 2;
  return st * 1024 + (ob ^ (((ob >> 9) & 1) << 5));
}
__device__ __forceinline__ void stage_rc(int b, int& R, int& C) {
  int st = b / 1024, sb = b % 1024, swz = sb ^ (((sb >> 9) & 1) << 5);
  R = (st >> 1) * 16 + swz / 64; C = (st & 1) * 32 + (swz % 64) / 2;
}
__device__ __forceinline__ bool tile_order(int i, int nM, int nN, int& pm, int& pn) {
  const int nwg = nM * nN; const int L = i * (int)gridDim.x + (int)blockIdx.x; if (L >= nwg) return false;
  int wgid = (int)L; { const int q = nwg / 8, r = nwg % 8, xcd = wgid % 8, off = wgid / 8; wgid = (xcd < r ? xcd * (q + 1) : r * (q + 1) + (xcd - r) * q) + off; }
  const int nig = 8 * nN, gid = wgid / nig, fm = gid * 8, gsz = (nM - fm) < 8 ? (nM - fm) : 8;
  pm = fm + ((wgid % nig) % gsz); pn = (wgid % nig) / gsz; return true;
}

#define LAS __attribute__((address_space(3)))
constexpr int HTB = HALFT * BK * 2;
struct GU { const char* A; const char* B; int lda, ldb, nt, brow, bcol, aux; };

template <class Prov, class Epi>
__device__ __forceinline__ void gemm_stream(Prov prov, Epi epi) {
  LAS unsigned char* lds = (LAS unsigned char*)smem;
  const int tid = tidx();
  const int wid = __builtin_amdgcn_readfirstlane(tid >> 6), lane = tid & 63, wr = wid >> 2, wc = wid & 3, fr = lane & 15, fq = lane >> 4;
  int sR[2], sC[2];
#pragma unroll
  for (int i = 0; i < 2; ++i) stage_rc(tid * 16 + i * 8192, sR[i], sC[i]);
  const size_t kstep = (size_t)(BK * 2);
  const unsigned ldsw = (unsigned)wid * 1024u;
  const int aoff = lds_byte(wr * 64 + fr, fq * 8), boff = lds_byte(wc * 32 + fr, fq * 8);
  GU cur, nxt;
  if (!prov(0, cur)) return;
  int ui = 0;
#define GSA(b, h) (((b)*2 + (h)) * HTB)
#define GSB(b, h) ((4 + (b)*2 + (h)) * HTB)
#define STAGE(bufoff, gbase, ld) do { _Pragma("unroll") for (int _i = 0; _i < 2; ++_i) \
    __builtin_amdgcn_global_load_lds((const unsigned*)((const char*)(gbase) + (unsigned)((sR[_i] * (ld) + sC[_i]) * 2)), (LAS unsigned*)(lds + (bufoff) + ldsw + _i * 8192), 16, 0, 0); } while (0)
#define LDA(dst, b, h) do { _Pragma("unroll") for (int m = 0; m < 4; ++m) _Pragma("unroll") for (int k = 0; k < 2; ++k) dst[m][k] = *(const LAS h8*)(lds + GSA(b, h) + aoff + m * 2048 + k * 1024); } while (0)
#define LDB(dst, b, h) do { _Pragma("unroll") for (int n = 0; n < 2; ++n) _Pragma("unroll") for (int k = 0; k < 2; ++k) dst[n][k] = *(const LAS h8*)(lds + GSB(b, h) + boff + n * 2048 + k * 1024); } while (0)
#define MMA(ai, bj, At_, Bt_) do { __builtin_amdgcn_s_setprio(1); _Pragma("unroll") for (int m = 0; m < 4; ++m) _Pragma("unroll") for (int n = 0; n < 2; ++n) _Pragma("unroll") for (int k = 0; k < 2; ++k) \
      acc[ai][bj][m][n] = __builtin_amdgcn_mfma_f32_16x16x32_f16(Bt_[n][k], At_[m][k], acc[ai][bj][m][n], 0, 0, 0); \
    __builtin_amdgcn_s_setprio(0); } while (0)
#define WAIT_V(n) asm volatile("s_waitcnt vmcnt(" #n ")" ::: "memory")
#define WAIT_L(n) asm volatile("s_waitcnt lgkmcnt(" #n ")" ::: "memory")
#define BAR __builtin_amdgcn_s_barrier()
#define SCHED __builtin_amdgcn_sched_barrier(0)
#define ZERO_ACC _Pragma("unroll") for (int a = 0; a < 2; ++a) _Pragma("unroll") for (int b = 0; b < 2; ++b) _Pragma("unroll") for (int m = 0; m < 4; ++m) _Pragma("unroll") for (int n = 0; n < 2; ++n) acc[a][b][m][n] = (f4){0.f, 0.f, 0.f, 0.f}
  f4 acc[2][2][4][2];
  ZERO_ACC;
  h8 At[4][2], B0[2][2], B1[2][2];
  { const size_t hA = (size_t)HALFT * cur.lda * 2, hB = (size_t)HALFT * cur.ldb * 2;
    STAGE(GSB(0, 0), cur.B, cur.ldb); STAGE(GSB(0, 1), cur.B + hB, cur.ldb); STAGE(GSA(0, 0), cur.A, cur.lda); STAGE(GSA(0, 1), cur.A + hA, cur.lda);
    if (wr == 1) BAR;
    WAIT_V(2); BAR;
    STAGE(GSB(1, 0), cur.B + kstep, cur.ldb); STAGE(GSA(1, 0), cur.A + kstep, cur.lda); STAGE(GSB(1, 1), cur.B + hB + kstep, cur.ldb);
    WAIT_V(6); BAR; }
#pragma unroll 1
  for (;;) {
    const bool has_next = prov(ui + 1, nxt);
    if (!has_next) nxt = cur;
    const int nt = cur.nt;
    const size_t hA = (size_t)HALFT * cur.lda * 2;
#pragma unroll 1
    for (int t = 0; t < nt; t += 2) {
      const bool last = (t + 2 >= nt);
      const char* a1 = cur.A + (size_t)(t + 1) * kstep + hA;
      const char* a2 = last ? nxt.A : cur.A + (size_t)(t + 2) * kstep;
      const char* b2 = last ? nxt.B : cur.B + (size_t)(t + 2) * kstep;
      const int lda2 = last ? nxt.lda : cur.lda, ldb2 = last ? nxt.ldb : cur.ldb;
      const size_t hA2 = (size_t)HALFT * lda2 * 2, hB2 = (size_t)HALFT * ldb2 * 2;
      LDB(B0, 0, 0); LDB(B1, 0, 1); SCHED; LDA(At, 0, 0); STAGE(GSA(1, 1), a1, cur.lda);
      WAIT_V(8); WAIT_L(0); BAR; MMA(0, 0, At, B0); MMA(0, 1, At, B1); BAR; SCHED;
      LDA(At, 0, 1); STAGE(GSB(0, 0), b2, ldb2); STAGE(GSB(0, 1), b2 + hB2, ldb2); STAGE(GSA(0, 0), a2, lda2);
      WAIT_V(8); WAIT_L(0); BAR; MMA(1, 0, At, B0); MMA(1, 1, At, B1); BAR; SCHED;
      LDB(B0, 1, 0); LDB(B1, 1, 1); SCHED; LDA(At, 1, 0); STAGE(GSA(0, 1), a2 + hA2, lda2);
      WAIT_V(8); WAIT_L(0); BAR; MMA(0, 0, At, B0); MMA(0, 1, At, B1); BAR; SCHED;
      LDA(At, 1, 1); STAGE(GSB(1, 0), b2 + kstep, ldb2); STAGE(GSB(1, 1), b2 + hB2 + kstep, ldb2); STAGE(GSA(1, 0), a2 + kstep, lda2);
      WAIT_V(8); WAIT_L(0); BAR; MMA(1, 0, At, B0); MMA(1, 1, At, B1); BAR; SCHED;
    }
    if (wr == 0) BAR;
    epi(acc, cur, wr, wc, fr, fq);
    ZERO_ACC;
    if (!has_next) break;
    cur = nxt; ++ui;
    if (wr == 1) BAR;
  }
  asm volatile("s_waitcnt vmcnt(0)" ::: "memory");
  __syncthreads();
#undef GSA
#undef GSB
#undef STAGE
#undef LDA
#undef LDB
#undef MMA
#undef ZERO_ACC
}

#define EPI_ARGS f4 (&acc)[2][2][4][2], const GU& d, int wr, int wc, int fr, int fq
#define EPI_ROWS _Pragma("unroll") for (int ai = 0; ai < 2; ++ai) _Pragma("unroll") for (int m = 0; m < 4; ++m)
#define EPI_COLS _Pragma("unroll") for (int bj = 0; bj < 2; ++bj) _Pragma("unroll") for (int n = 0; n < 2; ++n)
#define AINL __attribute__((always_inline))

__device__ __forceinline__ float sigmoidf_(float x) { return __builtin_amdgcn_rcpf(1.0f + __builtin_amdgcn_exp2f(-1.4426950408889634f * x)); }
__device__ __forceinline__ h4 cvt4(f4 v) { h4 r; r[0] = (hf)v[0]; r[1] = (hf)v[1]; r[2] = (hf)v[2]; r[3] = (hf)v[3]; return r; }
__device__ __forceinline__ h8 cvt8(f4 a, f4 b) { h8 r; r[0] = (hf)a[0]; r[1] = (hf)a[1]; r[2] = (hf)a[2]; r[3] = (hf)a[3]; r[4] = (hf)b[0]; r[5] = (hf)b[1]; r[6] = (hf)b[2]; r[7] = (hf)b[3]; return r; }
#define EPI_BJ _Pragma("unroll") for (int bj = 0; bj < 2; ++bj)
__device__ __forceinline__ void set_gu(GU& d, const hf* A, int lda, const hf* B, int ldb, int K, int brow, int bcol, int aux) {
  d.A = (const char*)(A + (size_t)brow * lda); d.B = (const char*)(B + (size_t)bcol * ldb); d.lda = lda; d.ldb = ldb; d.nt = K / BK; d.brow = brow; d.bcol = bcol; d.aux = aux;
}

__device__ __forceinline__ void phase_ffn_a(KP p, const hf* w_in, bool with_kv) {
  hf* hidden = p->aq; hf* kvc = p->kvc;
  const hf* x16 = p->x16; const hf* memn = p->memn; const hf* wkv = p->wkv;
  const int nA = 128 * 22, total = nA + (with_kv ? 256 : 0);
  gemm_stream([&](int i, GU& d) AINL -> bool {
      const int L = i * (int)gridDim.x + (int)blockIdx.x; if (L >= total) return false;
      if (L < nA) {
        int wgid = (int)L; const int q = nA / 8, off = wgid / 8, xcd = wgid % 8; wgid = xcd * q + off;
        const int nig = 8 * 22, gid = wgid / nig, fm = gid * 8, pm = fm + ((wgid % nig) % 8), pn = (wgid % nig) / 8;
        set_gu(d, x16, 1024, w_in, 1024, 1024, pm * 256, pn * 256, 0);
      } else {
        const int t = (int)L - nA, l = t >> 6, pm = (t & 63) >> 2, pn = t & 3;
        set_gu(d, memn, 1024, wkv + (size_t)l * 1024 * 1024, 1024, 1024, pm * 256, pn * 256, 1 + l);
      }
      return true; },
    [&](EPI_ARGS) AINL {
      if (d.aux == 0) {
        EPI_ROWS { const long row = d.brow + ai * 128 + wr * 64 + m * 16 + fr;
          f4 v[2];
          _Pragma("unroll") for (int n = 0; n < 2; ++n) { const f4 g = acc[ai][0][m][n], u = acc[ai][1][m][n];
            _Pragma("unroll") for (int j = 0; j < 4; ++j) v[n][j] = g[j] * sigmoidf_(g[j]) * u[j]; }
          *(h8*)(hidden + row * FFN + (d.bcol >> 1) + wc * 32 + fq * 8) = cvt8(v[0], v[1]); }
      } else {
        hf* dst = kvc + (size_t)(d.aux - 1) * 4096 * 1024;
        EPI_ROWS { const long row = d.brow + ai * 128 + wr * 64 + m * 16 + fr;
          EPI_BJ { *(h8*)(dst + row * 1024 + d.bcol + bj * 128 + wc * 32 + fq * 8) = cvt8(acc[ai][bj][m][0], acc[ai][bj][m][1]); } }
      } });
}

__device__ __forceinline__ void phase_resid(KP p, const hf* A, int lda, const hf* Wt, int K, float scale) {
  hf* y16 = p->s5tmp; const hf* res = p->x16;
  gemm_stream([&](int i, GU& d) AINL -> bool { int pm, pn; if (!tile_order(i, 128, 4, pm, pn)) return false; set_gu(d, A, lda, Wt, K, K, pm * 256, pn * 256, 0); return true; },
    [&](EPI_ARGS) AINL {
      EPI_ROWS { const long row = d.brow + ai * 128 + wr * 64 + m * 16 + fr;
        EPI_BJ { const long o = row * 1024 + d.bcol + bj * 128 + wc * 32 + fq * 8;
          const h8 r = *(const h8*)(res + o); f4 v0 = acc[ai][bj][m][0], v1 = acc[ai][bj][m][1];
          _Pragma("unroll") for (int j = 0; j < 4; ++j) { v0[j] = DN_ALPHA * (float)r[j] + scale * v0[j]; v1[j] = DN_ALPHA * (float)r[4 + j] + scale * v1[j]; }
          *(h8*)(y16 + o) = cvt8(v0, v1); } } });
}

__device__ __forceinline__ void phase_resid_ln(KP p, const hf* A, int lda, const hf* Wt, int K, float scale, const float* lng, const float* lnb, float* out32, int seq) {
  hf* x16 = p->x16; unsigned long long* xs = p->xstat; unsigned* pcnt = p->counters + 4096;
  gemm_stream([&](int i, GU& d) AINL -> bool { int pm, pn; if (!tile_order(i, 128, 4, pm, pn)) return false; set_gu(d, A, lda, Wt, K, K, pm * 256, pn * 256, pn); return true; },
    [&](EPI_ARGS) AINL {
      LAS float* P = (LAS float*)((LAS unsigned char*)smem + 131072);
      const int tid = tidx();
      EPI_ROWS { const int rl = ai * 128 + wr * 64 + m * 16 + fr; const long row = d.brow + rl; float s = 0.f, q = 0.f;
        EPI_BJ { const long o = row * 1024 + d.bcol + bj * 128 + wc * 32 + fq * 8; const h8 r = *(const h8*)(x16 + o);
          _Pragma("unroll") for (int j = 0; j < 4; ++j) { const float a0 = DN_ALPHA * (float)r[j] + scale * acc[ai][bj][m][0][j], a1 = DN_ALPHA * (float)r[4 + j] + scale * acc[ai][bj][m][1][j];
            acc[ai][bj][m][0][j] = a0; acc[ai][bj][m][1][j] = a1; s += a0 + a1; q += a0 * a0 + a1 * a1; } }
        s += __shfl_xor(s, 16); s += __shfl_xor(s, 32); q += __shfl_xor(q, 16); q += __shfl_xor(q, 32);
        if (fq == 0) { P[(rl * 4 + wc) * 2] = s; P[(rl * 4 + wc) * 2 + 1] = q; } }
      __syncthreads();
      if (tid < 256) { float s = 0.f, q = 0.f; _Pragma("unroll") for (int w4 = 0; w4 < 4; ++w4) { s += P[(tid * 4 + w4) * 2]; q += P[(tid * 4 + w4) * 2 + 1]; }
        const unsigned long long v = ((unsigned long long)__float_as_uint(q) << 32) | __float_as_uint(s);
        __hip_atomic_store(xs + (long)(d.brow + tid) * 4 + d.aux, v, __ATOMIC_RELAXED, __HIP_MEMORY_SCOPE_AGENT); }
      asm volatile("s_waitcnt vmcnt(0)" ::: "memory");
      __syncthreads();
      if (tid == 0) { unsigned* c = pcnt + (d.brow >> 8) * 16; __hip_atomic_fetch_add(c, 1u, __ATOMIC_RELAXED, __HIP_MEMORY_SCOPE_AGENT);
        const unsigned target = 4u * (unsigned)(seq + 1); unsigned sp = 0;
        while (__hip_atomic_load(c, __ATOMIC_RELAXED, __HIP_MEMORY_SCOPE_AGENT) < target) { __builtin_amdgcn_s_sleep(1); if (++sp > (1u << 22)) break; } }
      asm volatile("s_waitcnt vmcnt(0)" ::: "memory");
      __syncthreads();
      if (tid < 256) { float s = 0.f, q = 0.f;
        _Pragma("unroll") for (int pn = 0; pn < 4; ++pn) { const unsigned long long v = __hip_atomic_load(xs + (long)(d.brow + tid) * 4 + pn, __ATOMIC_RELAXED, __HIP_MEMORY_SCOPE_AGENT);
          s += __uint_as_float((unsigned)v); q += __uint_as_float((unsigned)(v >> 32)); }
        const float mu = s * (1.0f / 1024.0f), var = q * (1.0f / 1024.0f) - mu * mu;
        P[tid * 2] = mu; P[tid * 2 + 1] = rsqrtf(var + 1e-5f); }
      __syncthreads();
      EPI_ROWS { const int rl = ai * 128 + wr * 64 + m * 16 + fr; const long row = d.brow + rl; const float mu = P[rl * 2], rs = P[rl * 2 + 1];
        EPI_BJ { const int col = d.bcol + bj * 128 + wc * 32 + fq * 8; const long o = row * 1024 + col;
          const f4 g0 = *(const f4*)(lng + col), g1 = *(const f4*)(lng + col + 4), b0 = *(const f4*)(lnb + col), b1 = *(const f4*)(lnb + col + 4); f4 v0, v1;
          _Pragma("unroll") for (int j = 0; j < 4; ++j) { v0[j] = (acc[ai][bj][m][0][j] - mu) * rs * g0[j] + b0[j]; v1[j] = (acc[ai][bj][m][1][j] - mu) * rs * g1[j] + b1[j]; }
          *(h8*)(x16 + o) = cvt8(v0, v1);
          if (out32) { *(f4*)(out32 + o) = v0; *(f4*)(out32 + o + 4) = v1; } } }
      __syncthreads();
    });
}

__device__ __forceinline__ void phase_mix_a(KP p) {
  gemm_stream([&](int i, GU& d) AINL -> bool { int pm, pn; if (!tile_order(i, 128, 15, pm, pn)) return false; KP q = getp(); set_gu(d, q->x16, 1024, q->wmix, 1024, 1024, pm * 256, pn * 256, pn); return true; },
    [&](EPI_ARGS) AINL {
      const int pn = d.aux; hf* dst; int ldc, coff; KP q = getp();
      if (pn < 2) { dst = q->aq; ldc = 512; coff = pn * 256; }
      else if (pn == 2) { dst = q->akv; ldc = 256; coff = 0; }
      else if (pn < 5) { dst = q->dq; ldc = 512; coff = (pn - 3) * 256; }
      else if (pn < 7) { dst = q->dk; ldc = 512; coff = (pn - 5) * 256; }
      else if (pn < 9) { dst = q->dv; ldc = 512; coff = (pn - 7) * 256; }
      else if (pn < 11) { dst = q->su; ldc = 512; coff = (pn - 9) * 256; }
      else { dst = q->cu; ldc = 1024; coff = (pn - 11) * 256; }
      EPI_ROWS { const long row = d.brow + ai * 128 + wr * 64 + m * 16 + fr;
        EPI_BJ { *(h8*)(dst + row * ldc + coff + bj * 128 + wc * 32 + fq * 8) = cvt8(acc[ai][bj][m][0], acc[ai][bj][m][1]); } } });
}

__device__ __forceinline__ void phase_plain(const hf* A, int lda, const hf* Wt, int K, hf* dst, int ldc, int nM, int nN) {
  gemm_stream([&](int i, GU& d) AINL -> bool { int pm, pn; if (!tile_order(i, nM, nN, pm, pn)) return false; set_gu(d, A, lda, Wt, K, K, pm * 256, pn * 256, 0); return true; },
    [&](EPI_ARGS) AINL {
      EPI_ROWS { const long row = d.brow + ai * 128 + wr * 64 + m * 16 + fr;
        EPI_BJ { *(h8*)(dst + row * ldc + d.bcol + bj * 128 + wc * 32 + fq * 8) = cvt8(acc[ai][bj][m][0], acc[ai][bj][m][1]); } } });
}

__device__ __forceinline__ void phase_s5_glu(KP p, int l) {
  const float* gb = p->in[18] + l * 512; const hf* y = p->s5tmp; hf* dst = p->su; const hf* glu = p->glu;
  gemm_stream([&](int i, GU& d) AINL -> bool { int pm, pn; if (!tile_order(i, 128, 2, pm, pn)) return false; set_gu(d, y, 512, glu, 512, 512, pm * 256, pn * 256, 0); return true; },
    [&](EPI_ARGS) AINL {
      EPI_ROWS { const long row = d.brow + ai * 128 + wr * 64 + m * 16 + fr;
        EPI_BJ { const int col = d.bcol + bj * 128 + wc * 32 + fq * 8;
          const h8 yy = *(const h8*)(y + row * 512 + col); const f4 b0 = *(const f4*)(gb + col), b1 = *(const f4*)(gb + col + 4); f4 v0 = acc[ai][bj][m][0], v1 = acc[ai][bj][m][1];
          _Pragma("unroll") for (int j = 0; j < 4; ++j) { v0[j] = (float)yy[j] * sigmoidf_(v0[j] + b0[j]); v1[j] = (float)yy[4 + j] * sigmoidf_(v1[j] + b1[j]); }
          *(h8*)(dst + row * 512 + col) = cvt8(v0, v1); } } });
}

__device__ __forceinline__ void phase_merge(KP p) {
  gemm_stream([&](int idx, GU& d) AINL -> bool {
      const int it = idx >> 3, s = idx & 7, i = s >> 1; int pm, pn; if (!tile_order(it, 128, 4, pm, pn)) return false;
      KP q = getp();
      if ((s & 1) == 0) set_gu(d, q->x16, 1024, q->wmix + (size_t)(3840 + i * 1024) * 1024, 1024, 1024, pm * 256, pn * 256, s);
      else { const hf* A = i == 0 ? q->swo : i == 1 ? q->su : i == 2 ? q->convout : q->dfo; const hf* W = i == 0 ? q->pswa : i == 1 ? q->ps5 : i == 2 ? q->pconv : q->pdiff;
        set_gu(d, A, 512, W, 512, 512, pm * 256, pn * 256, s); }
      return true; },
    [&](EPI_ARGS) AINL {
      const int s = d.aux; KP q = getp(); hf* gbuf = q->dk; hf* merged = q->cu;
      if ((s & 1) == 0) {
        EPI_ROWS { const long row = d.brow + ai * 128 + wr * 64 + m * 16 + fr;
          EPI_BJ { f4 v0 = acc[ai][bj][m][0], v1 = acc[ai][bj][m][1]; _Pragma("unroll") for (int j = 0; j < 4; ++j) { v0[j] = sigmoidf_(v0[j]); v1[j] = sigmoidf_(v1[j]); }
            *(h8*)(gbuf + row * 1024 + d.bcol + bj * 128 + wc * 32 + fq * 8) = cvt8(v0, v1); } }
      } else {
        EPI_ROWS { const long row = d.brow + ai * 128 + wr * 64 + m * 16 + fr;
          EPI_BJ { const long o = row * 1024 + d.bcol + bj * 128 + wc * 32 + fq * 8;
            const h8 g = *(const h8*)(gbuf + o); f4 v0 = acc[ai][bj][m][0], v1 = acc[ai][bj][m][1];
            _Pragma("unroll") for (int j = 0; j < 4; ++j) { v0[j] *= (float)g[j]; v1[j] *= (float)g[4 + j]; }
            if (s > 1) { const h8 mo = *(const h8*)(merged + o); _Pragma("unroll") for (int j = 0; j < 4; ++j) { v0[j] += (float)mo[j]; v1[j] += (float)mo[4 + j]; } }
            *(h8*)(merged + o) = cvt8(v0, v1); } }
      } });
}

__device__ __forceinline__ float wave_sum(float v) {
  for (int o = 32; o > 0; o >>= 1) v += __shfl_xor(v, o);
  return v;
}

__device__ __forceinline__ void ln_rows(const float* src, const float* g, const float* b, float* dst32, hf* dst16, int nrows) {
  const int wave = blockIdx.x * 8 + (tidx() >> 6), nw = gridDim.x * 8, lane = tidx() & 63;
  f4 gg[4], bb[4];
  for (int i = 0; i < 4; ++i) { gg[i] = *(const f4*)(g + i * 256 + lane * 4); bb[i] = *(const f4*)(b + i * 256 + lane * 4); }
  for (int r = wave; r < nrows; r += nw) {
    f4 v[4]; float s = 0.f;
    for (int i = 0; i < 4; ++i) { v[i] = *(const f4*)(src + (long)r * 1024 + i * 256 + lane * 4); s += (v[i][0] + v[i][1]) + (v[i][2] + v[i][3]); }
    const float mu = wave_sum(s) * (1.0f / 1024.0f);
    float q = 0.f;
    for (int i = 0; i < 4; ++i) for (int j = 0; j < 4; ++j) { const float d = v[i][j] - mu; q += d * d; }
    const float rs = rsqrtf(wave_sum(q) * (1.0f / 1024.0f) + 1e-5f);
    for (int i = 0; i < 4; ++i) { f4 o; for (int j = 0; j < 4; ++j) o[j] = (v[i][j] - mu) * rs * gg[i][j] + bb[i][j];
      if (dst32) *(f4*)(dst32 + (long)r * 1024 + i * 256 + lane * 4) = o;
      *(h4*)(dst16 + (long)r * 1024 + i * 256 + lane * 4) = cvt4(o); }
  }
}

__device__ __forceinline__ void ln_rows16(const hf* src, const float* g, const float* b, float* dst32, hf* dst16, int nrows) {
  const int wave = blockIdx.x * 8 + (tidx() >> 6), nw = gridDim.x * 8, lane = tidx() & 63;
  f4 gg[4], bb[4];
  for (int i = 0; i < 4; ++i) { gg[i] = *(const f4*)(g + i * 256 + lane * 4); bb[i] = *(const f4*)(b + i * 256 + lane * 4); }
  for (int r = wave; r < nrows; r += nw) {
    f4 v[4]; float s = 0.f;
    for (int i = 0; i < 4; ++i) { const h4 t = *(const h4*)(src + (long)r * 1024 + i * 256 + lane * 4); v[i][0] = (float)t[0]; v[i][1] = (float)t[1]; v[i][2] = (float)t[2]; v[i][3] = (float)t[3];
      s += (v[i][0] + v[i][1]) + (v[i][2] + v[i][3]); }
    const float mu = wave_sum(s) * (1.0f / 1024.0f);
    float q = 0.f;
    for (int i = 0; i < 4; ++i) for (int j = 0; j < 4; ++j) { const float d = v[i][j] - mu; q += d * d; }
    const float rs = rsqrtf(wave_sum(q) * (1.0f / 1024.0f) + 1e-5f);
    for (int i = 0; i < 4; ++i) { f4 o; for (int j = 0; j < 4; ++j) o[j] = (v[i][j] - mu) * rs * gg[i][j] + bb[i][j];
      if (dst32) *(f4*)(dst32 + (long)r * 1024 + i * 256 + lane * 4) = o;
      *(h4*)(dst16 + (long)r * 1024 + i * 256 + lane * 4) = cvt4(o); }
  }
}

__device__ __forceinline__ void conv_w_job(const float* __restrict__ src, int ld, int K, hf* __restrict__ dst, int NBk  , int mode, int coloff) {
  float* tile = (float*)smem;
  const int nkb = K / 64, total = NBk * nkb, tid = tidx();
  for (int u = blockIdx.x; u < total; u += gridDim.x) {
    const int nb = u / nkb, kb = u % nkb;
    int c0;
    if (mode == 0) c0 = coloff + nb * 64;
    else { const int j = nb >> 2, sub = nb & 3; c0 = (sub < 2) ? (j * 128 + sub * 64) : (FFN + j * 128 + (sub - 2) * 64); }
    __syncthreads();
    for (int h = 0; h < 2; ++h) { const int kk = (tid >> 4) + h * 32, c4 = tid & 15;
      const f4 v = *(const f4*)(src + (long)(kb * 64 + kk) * ld + c0 + c4 * 4);
      for (int j = 0; j < 4; ++j) tile[kk * 65 + c4 * 4 + j] = v[j]; }
    __syncthreads();
    { const int n = tid >> 3, k8 = tid & 7; h8 o;
      const int rho = n & 31, ii = rho & 15, ns = (n & 32) + 8 * (ii >> 2) + 4 * (rho >> 4) + (ii & 3);
      for (int j = 0; j < 8; ++j) o[j] = (hf)tile[(k8 * 8 + j) * 65 + ns];
      *(h8*)(dst + (long)(nb * 64 + n) * K + kb * 64 + k8 * 8) = o; }
  }
}

__device__ __forceinline__ void convert_ffn(KP p, const float* w_in, const float* w_out, hf* din, hf* dout) {
  conv_w_job(w_in, 2 * FFN, 1024, din, 88, 1, 0);
  conv_w_job(w_out, 1024, FFN, dout, 16, 0, 0);
}
__device__ __forceinline__ void convert_mix(KP p, int l) {
  conv_w_job(p->in[6] + (long)l * 1024 * 7936, 7936, 1024, p->wmix, 124, 0, 0);
  conv_w_job(p->in[8] + (long)l * 512 * 1024, 1024, 512, p->pswa, 16, 0, 0);
  conv_w_job(p->in[19] + (long)l * 512 * 1024, 1024, 512, p->ps5, 16, 0, 0);
  conv_w_job(p->in[24] + (long)l * 512 * 1024, 1024, 512, p->pconv, 16, 0, 0);
  conv_w_job(p->in[30] + (long)l * 512 * 1024, 1024, 512, p->pdiff, 16, 0, 0);
  conv_w_job(p->in[17] + (long)l * 512 * 512, 512, 512, p->glu, 8, 0, 0);
  conv_w_job(p->in[31] + (long)l * 1024 * 1024, 1024, 1024, p->wout, 16, 0, 0);
}
__device__ __forceinline__ void convert_cross(KP p, int l) {
  conv_w_job(p->in[36] + (long)l * 1024 * 512, 512, 1024, p->wq, 8, 0, 0);
  conv_w_job(p->in[38] + (long)l * 512 * 1024, 1024, 512, p->wo, 16, 0, 0);
}

__device__ __forceinline__ void phase_init(KP p) {
  { const long n4 = (long)NTOK * 1024 / 4; const f4* s = (const f4*)p->in[0]; h4* d = (h4*)p->x16;
    for (long i = (long)blockIdx.x * 512 + tidx(); i < n4; i += (long)gridDim.x * 512) d[i] = cvt4(s[i]); }
  ln_rows(p->in[1], p->in[34], p->in[35], nullptr, p->memn, 4096);
  convert_ffn(p, p->in[2], p->in[3], p->wbin, p->wbout);
  for (int l = 0; l < 4; ++l) conv_w_job(p->in[37] + (long)l * 1024 * 1024, 1024, 1024, p->wkv + (long)l * 1024 * 1024, 16, 0, 0);
}

__device__ __forceinline__ h4 trrd(const hf* q) { return __builtin_bit_cast(h4, __builtin_amdgcn_ds_read_tr16_b64_v4i16((__attribute__((address_space(3))) s4v*)q)); }

template <int DK, int DV, int KW, bool ALIBI, int MASK>
__device__ __forceinline__ void attn_core(const hf* __restrict__ Kg, long kstride, const hf* __restrict__ Vg, long vstride, int T0, int T1,
                                          const hf* __restrict__ Qw, long qstride, int kcol, int q0, float c1, float c2,
                                          f4 (&O)[2][DV / 16], float (&m)[2], float (&l)[2]) {
  constexpr int KSTR = KW + 8, VSTR = DV + 8, KCH = KW / 8, VCH = DV / 8, NKL = 64 * KCH / 512, NVL = 64 * VCH / 512;
  hf* Ks = (hf*)smem; hf* Vs = Ks + 64 * KSTR;
  const int tid = tidx(), lane = tid & 63, fr = lane & 15, fq = lane >> 4;
  h8 qf[2][DK / 32];
#pragma unroll
  for (int qs = 0; qs < 2; ++qs)
#pragma unroll
    for (int ks = 0; ks < DK / 32; ++ks) qf[qs][ks] = *(const h8*)(Qw + (long)(qs * 16 + fr) * qstride + ks * 32 + fq * 8);
  h8 kreg[NKL], vreg[NVL];
#pragma unroll
  for (int i = 0; i < NKL; ++i) { const int idx = tid + i * 512, r = idx / KCH, c = idx % KCH; kreg[i] = *(const h8*)(Kg + (long)(T0 * 64 + r) * kstride + c * 8); }
#pragma unroll
  for (int i = 0; i < NVL; ++i) { const int idx = tid + i * 512, r = idx / VCH, c = idx % VCH; vreg[i] = *(const h8*)(Vg + (long)(T0 * 64 + r) * vstride + c * 8); }
#pragma unroll 1
  for (int T = T0; T < T1; ++T) {
    __syncthreads();
#pragma unroll
    for (int i = 0; i < NKL; ++i) { const int idx = tid + i * 512, r = idx / KCH, c = idx % KCH; *(h8*)(Ks + r * KSTR + c * 8) = kreg[i]; }
#pragma unroll
    for (int i = 0; i < NVL; ++i) { const int idx = tid + i * 512, r = idx / VCH, c = idx % VCH; *(h8*)(Vs + r * VSTR + c * 8) = vreg[i]; }
    __syncthreads();
    if (T + 1 < T1) {
#pragma unroll
      for (int i = 0; i < NKL; ++i) { const int idx = tid + i * 512, r = idx / KCH, c = idx % KCH; kreg[i] = *(const h8*)(Kg + (long)((T + 1) * 64 + r) * kstride + c * 8); }
#pragma unroll
      for (int i = 0; i < NVL; ++i) { const int idx = tid + i * 512, r = idx / VCH, c = idx % VCH; vreg[i] = *(const h8*)(Vg + (long)((T + 1) * 64 + r) * vstride + c * 8); }
    }
    bool rel = true;
    if (MASK >= 1) rel = (T * 64 <= q0 + 31);
    if (MASK == 2) rel = rel && (T * 64 + 63 >= q0 - 127);
    if (rel) {
      f4 S[2][4];
#pragma unroll
      for (int kt = 0; kt < 4; ++kt) {
#pragma unroll
        for (int qs = 0; qs < 2; ++qs) S[qs][kt] = (f4){0.f, 0.f, 0.f, 0.f};
#pragma unroll
        for (int ks = 0; ks < DK / 32; ++ks) {
          const h8 kf = *(const h8*)(Ks + (kt * 16 + fr) * KSTR + kcol + ks * 32 + fq * 8);
#pragma unroll
          for (int qs = 0; qs < 2; ++qs) S[qs][kt] = __builtin_amdgcn_mfma_f32_16x16x32_f16(kf, qf[qs][ks], S[qs][kt], 0, 0, 0);
        }
      }
      h8 pf[2][2];
#pragma unroll
      for (int qs = 0; qs < 2; ++qs) {
        const int qp = q0 + qs * 16 + fr;
        float mx = m[qs];
        const float abase = ALIBI ? c2 * (float)(T * 64 + fq * 4 - qp) : 0.f;
        const bool need_mask = (MASK == 2) || (MASK == 1 && (T * 64 + 63 > q0));
        if (need_mask) {
#pragma unroll
          for (int kt = 0; kt < 4; ++kt)
#pragma unroll
            for (int jj = 0; jj < 4; ++jj) {
              const int kp = T * 64 + kt * 16 + fq * 4 + jj;
              float s = fmaf(S[qs][kt][jj], c1, ALIBI ? fmaf(c2, (float)(kt * 16 + jj), abase) : 0.f);
              if (MASK == 1) s = (kp <= qp) ? s : -1e30f;
              if (MASK == 2) s = (kp <= qp && qp - kp < 128) ? s : -1e30f;
              S[qs][kt][jj] = s; mx = fmaxf(mx, s);
            }
        } else {
#pragma unroll
          for (int kt = 0; kt < 4; ++kt)
#pragma unroll
            for (int jj = 0; jj < 4; ++jj) {
              const float s = fmaf(S[qs][kt][jj], c1, ALIBI ? fmaf(c2, (float)(kt * 16 + jj), abase) : 0.f);
              S[qs][kt][jj] = s; mx = fmaxf(mx, s);
            }
        }
        mx = fmaxf(mx, __shfl_xor(mx, 16)); mx = fmaxf(mx, __shfl_xor(mx, 32));
        const float alpha = __builtin_amdgcn_exp2f(m[qs] - mx); m[qs] = mx;
        float ps = 0.f;
#pragma unroll
        for (int kt = 0; kt < 4; ++kt)
#pragma unroll
          for (int jj = 0; jj < 4; ++jj) { const float pv = __builtin_amdgcn_exp2f(S[qs][kt][jj] - mx); ps += pv; S[qs][kt][jj] = pv; }
        l[qs] = l[qs] * alpha + ps;
#pragma unroll
        for (int et = 0; et < DV / 16; ++et) O[qs][et] *= alpha;
#pragma unroll
        for (int pr = 0; pr < 2; ++pr)
#pragma unroll
          for (int jj = 0; jj < 4; ++jj) { pf[qs][pr][jj] = (hf)S[qs][2 * pr][jj]; pf[qs][pr][4 + jj] = (hf)S[qs][2 * pr + 1][jj]; }
      }
#pragma unroll
      for (int pr = 0; pr < 2; ++pr)
#pragma unroll
        for (int et = 0; et < DV / 16; ++et) {
          const h4 v0 = trrd(Vs + (pr * 32 + fq * 4 + (fr >> 2)) * VSTR + et * 16 + (fr & 3) * 4);
          const h4 v1 = trrd(Vs + (pr * 32 + 16 + fq * 4 + (fr >> 2)) * VSTR + et * 16 + (fr & 3) * 4);
          h8 vf; vf[0] = v0[0]; vf[1] = v0[1]; vf[2] = v0[2]; vf[3] = v0[3]; vf[4] = v1[0]; vf[5] = v1[1]; vf[6] = v1[2]; vf[7] = v1[3];
#pragma unroll
          for (int qs = 0; qs < 2; ++qs) O[qs][et] = __builtin_amdgcn_mfma_f32_16x16x32_f16(vf, pf[qs][pr], O[qs][et], 0, 0, 0);
        }
    }
  }
}

__device__ __forceinline__ void swa_unit(KP p, int l, int u) {
  const int hp = u & 1, n = (u >> 1) & 15, g = (u >> 5) & 1, b = u >> 6;
  const int w = tidx() >> 6, lane = tidx() & 63, fr = lane & 15, fq = lane >> 4;
  const int hq = g * 4 + hp * 2 + (w >> 2), q0 = n * 128 + (w & 3) * 32;
  const hf* Kg = p->akv + (long)b * SEQ * 256 + g * 64; const hf* Vg = Kg + 128;
  hf* Qw = p->aq + ((long)b * SEQ + q0) * 512 + hq * 64;
  hf* Ow = p->swo + ((long)b * SEQ + q0) * 512 + hq * 64;
  const float slope = exp2f(-(float)(hq + 1));
  f4 O[2][4]; float m[2], ls[2];
  const float sink = p->in[7][l * 8 + hq] * LOG2E;
  for (int qs = 0; qs < 2; ++qs) { m[qs] = sink; ls[qs] = (fq == 0) ? 1.f : 0.f; for (int et = 0; et < 4; ++et) O[qs][et] = (f4){0.f, 0.f, 0.f, 0.f}; }
  const int T0 = (2 * n - 2) < 0 ? 0 : (2 * n - 2), T1 = 2 * n + 2;
  attn_core<64, 64, 64, true, 2>(Kg, 256, Vg, 256, T0, T1, Qw, 512, 0, q0, 0.125f * LOG2E, slope * LOG2E, O, m, ls);
  for (int qs = 0; qs < 2; ++qs) {
    float lt = ls[qs]; lt += __shfl_xor(lt, 16); lt += __shfl_xor(lt, 32);
    const float inv = 1.0f / lt;
    for (int et = 0; et < 4; ++et) *(h4*)(Ow + (long)(qs * 16 + fr) * 512 + et * 16 + fq * 4) = cvt4(O[qs][et] * inv);
  }
}

__device__ __forceinline__ void diff_unit(KP p, int l, int u) {
  const int n = 15 - (u >> 6), h = u & 3, b = (u >> 2) & 15;
  const int w = tidx() >> 6, lane = tidx() & 63, fr = lane & 15, fq = lane >> 4;
  const int comp = w & 1, q0 = n * 128 + (w >> 1) * 32;
  const hf* Kg = p->dk + (long)b * SEQ * 512 + h * 128; const hf* Vg = p->dv + (long)b * SEQ * 512 + h * 128;
  hf* Qrow = p->dq + ((long)b * SEQ + q0) * 512 + h * 128;
  hf* Orow = p->dfo + ((long)b * SEQ + q0) * 512 + h * 128;
  const float slope = exp2f(-2.0f * (float)(h + 1));
  const float lambda_init = 0.8f - 0.6f * expf(-0.3f * (float)l);
  float lam;
  { const float a = p->in[25][l * 64 + lane] * p->in[26][l * 64 + lane], c = p->in[27][l * 64 + lane] * p->in[28][l * 64 + lane];
    lam = expf(wave_sum(a)) - expf(wave_sum(c)) + lambda_init; }
  f4 O[2][8]; float m[2], ls[2];
  for (int qs = 0; qs < 2; ++qs) { m[qs] = -1e30f; ls[qs] = 0.f; for (int et = 0; et < 8; ++et) O[qs][et] = (f4){0.f, 0.f, 0.f, 0.f}; }
  attn_core<64, 128, 128, true, 1>(Kg, 512, Vg, 512, 0, 2 * n + 2, Qrow + comp * 64, 512, comp * 64, q0, 0.125f * LOG2E, slope * LOG2E, O, m, ls);
  float inv[2];
  for (int qs = 0; qs < 2; ++qs) { float lt = ls[qs]; lt += __shfl_xor(lt, 16); lt += __shfl_xor(lt, 32); inv[qs] = 1.0f / lt; }
  __syncthreads();
  float* XS = (float*)smem + (w >> 1) * 4096;
  if (comp == 1) {
    for (int qs = 0; qs < 2; ++qs) for (int et = 0; et < 8; ++et) for (int jj = 0; jj < 4; ++jj) XS[((qs * 8 + et) * 4 + jj) * 64 + lane] = O[qs][et][jj] * inv[qs];
  }
  __syncthreads();
  if (comp == 0) {
    const float* ng = p->in[29] + l * 128;
    for (int qs = 0; qs < 2; ++qs) {
      float ss = 0.f;
      for (int et = 0; et < 8; ++et) for (int jj = 0; jj < 4; ++jj) { const float v = O[qs][et][jj] * inv[qs] - lam * XS[((qs * 8 + et) * 4 + jj) * 64 + lane]; O[qs][et][jj] = v; ss += v * v; }
      ss += __shfl_xor(ss, 16); ss += __shfl_xor(ss, 32);
      const float r = rsqrtf(ss * (1.0f / 128.0f) + 1e-5f) * (1.0f - lambda_init);
      for (int et = 0; et < 8; ++et) { const f4 g4 = *(const f4*)(ng + et * 16 + fq * 4); f4 v = O[qs][et];
        for (int jj = 0; jj < 4; ++jj) v[jj] = v[jj] * r * g4[jj];
        *(h4*)(Orow + (long)(qs * 16 + fr) * 512 + et * 16 + fq * 4) = cvt4(v); }
    }
  }
}

__device__ __forceinline__ void cross_unit(KP p, int l, int u) {
  const int qb = u & 7, h = (u >> 3) & 3, b = u >> 5;
  const int w = tidx() >> 6, lane = tidx() & 63, fr = lane & 15, fq = lane >> 4;
  const int q0 = qb * 256 + w * 32;
  const hf* Kg = p->kvc + (long)l * 4096 * 1024 + (long)b * 256 * 1024 + h * 128; const hf* Vg = Kg + 512;
  const hf* Qw = p->aq + ((long)b * SEQ + q0) * 512 + h * 128;
  hf* Ow = p->dq + ((long)b * SEQ + q0) * 512 + h * 128;
  f4 O[2][8]; float m[2], ls[2];
  for (int qs = 0; qs < 2; ++qs) { m[qs] = -1e30f; ls[qs] = 0.f; for (int et = 0; et < 8; ++et) O[qs][et] = (f4){0.f, 0.f, 0.f, 0.f}; }
  attn_core<128, 128, 128, false, 0>(Kg, 1024, Vg, 1024, 0, 4, Qw, 512, 0, q0, 0.08838834764831845f * LOG2E, 0.f, O, m, ls);
  for (int qs = 0; qs < 2; ++qs) {
    float lt = ls[qs]; lt += __shfl_xor(lt, 16); lt += __shfl_xor(lt, 32);
    const float inv = 1.0f / lt;
    for (int et = 0; et < 8; ++et) *(h4*)(Ow + (long)(qs * 16 + fr) * 512 + et * 16 + fq * 4) = cvt4(O[qs][et] * inv);
  }
}

__device__ __forceinline__ void s5_unit(KP p, int l, int u) {
  const int b = u >> 2, w = tidx() >> 6, g = (u & 3) * 8 + w, lane = tidx() & 63, fr = lane & 15, fq = lane >> 4;
  float* BuS = (float*)(smem + w * 12800);
  float* Yt = BuS + 16 * 132;
  const int lg = l * 32 + g;
  const float step = expf(p->in[11][lg]);
  float abr, abi;
  { const float ar = p->in[9][lg * 64 + lane], ai = p->in[10][lg * 64 + lane]; const float mag = expf(ar * step); abr = mag * cosf(ai * step); abi = mag * sinf(ai * step); }
  h8 bfr[8];
#pragma unroll
  for (int nt = 0; nt < 8; ++nt) {
    const int pp = (nt & 3) * 16 + fr;
    const float ar = p->in[9][lg * 64 + pp], ai = p->in[10][lg * 64 + pp]; const float mag = expf(ar * step);
    const float nr = mag * cosf(ai * step) - 1.0f, ni = mag * sinf(ai * step), den = ar * ar + ai * ai;
    const float cr = (nr * ar + ni * ai) / den, ci = (ni * ar - nr * ai) / den;
    const float* brp = p->in[12] + ((long)lg * 64 + pp) * 16 + (fq & 1) * 8; const float* bip = p->in[13] + ((long)lg * 64 + pp) * 16 + (fq & 1) * 8;
#pragma unroll
    for (int s = 0; s < 8; ++s) { const float v = (nt < 4) ? (cr * brp[s] - ci * bip[s]) : (cr * bip[s] + ci * brp[s]); bfr[nt][s] = (fq < 2) ? (hf)v : (hf)0.0f; }
  }
  h8 cfr[4];
#pragma unroll
  for (int ks = 0; ks < 4; ++ks) {
    const float* src = (ks < 2 ? p->in[14] : p->in[15]) + ((long)lg * 16 + fr) * 64 + (ks & 1) * 32 + fq * 8;
    const float sg = ks < 2 ? 1.0f : -1.0f;
#pragma unroll
    for (int j = 0; j < 8; ++j) cfr[ks][j] = (hf)(sg * src[j]);
  }
  h8 dfr;
  { const float dd = p->in[16][l * 512 + g * 16 + fr];
#pragma unroll
    for (int s = 0; s < 8; ++s) dfr[s] = (fq < 2 && (fq & 1) * 8 + s == fr) ? (hf)dd : (hf)0.0f; }
  float xr = 0.f, xi = 0.f;
  const hf* up = p->su + (long)b * SEQ * 512 + g * 16 + (fq & 1) * 8;
  hf* yp = p->s5tmp + (long)b * SEQ * 512 + g * 16;
  h8 un = *(const h8*)(up + (long)fr * 512);
#pragma unroll 1
  for (int ch = 0; ch < 128; ++ch) {
    h8 uf = un;
    if (fq >= 2) { for (int s = 0; s < 8; ++s) uf[s] = (hf)0.0f; }
    if (ch < 127) un = *(const h8*)(up + (long)((ch + 1) * 16 + fr) * 512);
#pragma unroll
    for (int nt = 0; nt < 8; ++nt) {
      const f4 d = __builtin_amdgcn_mfma_f32_16x16x32_f16(uf, bfr[nt], (f4){0.f, 0.f, 0.f, 0.f}, 0, 0, 0);
#pragma unroll
      for (int jj = 0; jj < 4; ++jj) BuS[(fq * 4 + jj) * 132 + nt * 16 + fr] = d[jj];
    }
    __syncthreads();
    float br_[16], bi_[16];
#pragma unroll
    for (int t = 0; t < 16; ++t) { br_[t] = BuS[t * 132 + lane]; bi_[t] = BuS[t * 132 + 64 + lane]; }
#pragma unroll
    for (int t = 0; t < 16; ++t) {
      const float nxr = abr * xr - abi * xi + br_[t], nxi = abr * xi + abi * xr + bi_[t]; xr = nxr; xi = nxi;
      BuS[t * 132 + lane] = xr; BuS[t * 132 + 64 + lane] = xi;
    }
    __syncthreads();
    f4 y = (f4){0.f, 0.f, 0.f, 0.f};
#pragma unroll
    for (int ks = 0; ks < 4; ++ks) {
      const f4 xa = *(const f4*)(BuS + fr * 132 + ks * 32 + fq * 8), xb = *(const f4*)(BuS + fr * 132 + ks * 32 + fq * 8 + 4);
      h8 xf; xf[0] = (hf)xa[0]; xf[1] = (hf)xa[1]; xf[2] = (hf)xa[2]; xf[3] = (hf)xa[3]; xf[4] = (hf)xb[0]; xf[5] = (hf)xb[1]; xf[6] = (hf)xb[2]; xf[7] = (hf)xb[3];
      y = __builtin_amdgcn_mfma_f32_16x16x32_f16(xf, cfr[ks], y, 0, 0, 0);
    }
    y = __builtin_amdgcn_mfma_f32_16x16x32_f16(uf, dfr, y, 0, 0, 0);
#pragma unroll
    for (int jj = 0; jj < 4; ++jj) {
      const float v = y[jj], z = 0.7978845608028654f * (v + 0.044715f * v * v * v);
      const float th = 1.0f - 2.0f * __builtin_amdgcn_rcpf(__builtin_amdgcn_exp2f(2.8853900817779268f * z) + 1.0f);
      Yt[(fq * 4 + jj) * 20 + fr] = 0.5f * v * (1.0f + th);
    }
    __syncthreads();
    { const int t = lane >> 2, c4 = (lane & 3) * 4; const f4 v = *(const f4*)(Yt + t * 20 + c4);
      *(h4*)(yp + (long)(ch * 16 + t) * 512 + c4) = cvt4(v); }
  }
}

__device__ __forceinline__ void conv_unit(KP p, int l, int u) {
  const int b = u >> 5, t0 = (u & 31) * 64, tid = tidx(), w = tid >> 6, lane = tid & 63;
  hf* G = (hf*)smem;
  hf* Wc = (hf*)(smem + 96256);
  for (int idx = tid; idx < 94 * 64; idx += 512) {
    const int r = idx >> 6, c8 = idx & 63, t = t0 - 30 + r; h8 o;
    if (t >= 0) { const hf* src = p->cu + ((long)b * SEQ + t) * 1024 + c8 * 8; const h8 v = *(const h8*)src, gt = *(const h8*)(src + 512);
      for (int j = 0; j < 8; ++j) o[j] = (hf)((float)v[j] * sigmoidf_((float)gt[j])); }
    else { for (int j = 0; j < 8; ++j) o[j] = (hf)0.0f; }
    *(h8*)(G + r * 512 + c8 * 8) = o;
  }
  { const float* cw = p->in[20] + (long)l * 31 * 512; for (int idx = tid; idx < 31 * 512; idx += 512) Wc[idx] = (hf)cw[idx]; }
  __syncthreads();
  const float* cb = p->in[21] + l * 512 + lane * 8; const f4 b0 = *(const f4*)cb, b1 = *(const f4*)(cb + 4);
  const float* lg = p->in[22] + l * 512 + lane * 8; const float* lb = p->in[23] + l * 512 + lane * 8;
  const f4 g0 = *(const f4*)lg, g1 = *(const f4*)(lg + 4), c0 = *(const f4*)lb, c1 = *(const f4*)(lb + 4);
#pragma unroll 1
  for (int jp = 0; jp < 4; ++jp) {
    float a0[8], a1[8];
#pragma unroll
    for (int c = 0; c < 8; ++c) { a0[c] = c < 4 ? b0[c & 3] : b1[c & 3]; a1[c] = a0[c]; }
    const hf* gp = G + (w * 8 + jp * 2) * 512 + lane * 8;
    h8 wprev;
#pragma unroll
    for (int c = 0; c < 8; ++c) wprev[c] = (hf)0.0f;
#pragma unroll 8
    for (int k = 0; k < 32; ++k) {
      const h8 gv = *(const h8*)(gp + k * 512);
      h8 wv;
      if (k < 31) wv = *(const h8*)(Wc + k * 512 + lane * 8); else { for (int c = 0; c < 8; ++c) wv[c] = (hf)0.0f; }
#pragma unroll
      for (int c = 0; c < 8; ++c) { a0[c] += (float)gv[c] * (float)wv[c]; a1[c] += (float)gv[c] * (float)wprev[c]; }
      wprev = wv;
    }
#pragma unroll
    for (int jj = 0; jj < 2; ++jj) {
      float s = 0.f;
#pragma unroll
      for (int c = 0; c < 8; ++c) s += jj ? a1[c] : a0[c];
      const float mu = wave_sum(s) * (1.0f / 512.0f);
      float q = 0.f;
#pragma unroll
      for (int c = 0; c < 8; ++c) { const float d = (jj ? a1[c] : a0[c]) - mu; q += d * d; }
      const float rs = rsqrtf(wave_sum(q) * (1.0f / 512.0f) + 1e-5f);
      h8 o;
#pragma unroll
      for (int c = 0; c < 8; ++c) { const float gg = c < 4 ? g0[c & 3] : g1[c & 3], bb = c < 4 ? c0[c & 3] : c1[c & 3];
        const float v = ((jj ? a1[c] : a0[c]) - mu) * rs * gg + bb; o[c] = (hf)(v * sigmoidf_(v)); }
      *(h8*)(p->convout + ((long)b * SEQ + t0 + w * 8 + jp * 2 + jj) * 512 + lane * 8) = o;
    }
  }
}

__device__ __forceinline__ void phase_mixers(KP p, int l, int cidx) {
  volatile int* ctl = (volatile int*)(smem + CTL_OFF);
  const int NS5 = 64, NDIFF = 1024, NSWA = 1024, NCONV = 512, TOTAL = NS5 + NDIFF + NSWA + NCONV;
  for (;;) {
    __syncthreads();
    if (tidx() == 0) *ctl = (int)atomicAdd(p->counters + cidx, 1u);
    __syncthreads();
    const int it = *ctl;
    if (it >= TOTAL) break;
    if (it < NS5) s5_unit(p, l, it);
    else if (it < NS5 + NDIFF) diff_unit(p, l, it - NS5);
    else if (it < NS5 + NDIFF + NSWA) swa_unit(p, l, it - NS5 - NDIFF);
    else conv_unit(p, l, it - NS5 - NDIFF - NSWA);
  }
}
__device__ __forceinline__ void phase_cross_attn(KP p, int l) {
  for (int u = blockIdx.x; u < 512; u += gridDim.x) { __syncthreads(); cross_unit(p, l, u); }
}

__global__ void __launch_bounds__(512) fwd_megakernel(Params pv) {
  cg::grid_group grid = cg::this_grid();
  if (tidx() == 0) { const unsigned long long kp = (unsigned long long)__builtin_amdgcn_kernarg_segment_ptr();
    volatile __attribute__((address_space(3))) unsigned* s = (volatile __attribute__((address_space(3))) unsigned*)(smem + 136 * 1024 + 16);
    s[0] = (unsigned)kp; s[1] = (unsigned)(kp >> 32); s[4] = 0u; s[5] = 0u; }
  __syncthreads();
  if (tidx() == 0) (void)xb_add(&getp()->counters[XB_XCNT(xb_xcc_id())], 1u);
  phase_init(getp());
  grid.sync();
#pragma unroll 1
  for (int j = 0; j < 8; ++j) {
    const int l = j >> 1, second = j & 1;
    phase_ffn_a(getp(), second ? getp()->w1in : getp()->wbin, j == 0);
    gbar();
    phase_resid_ln(getp(), getp()->aq, FFN, second ? getp()->w1out : getp()->wbout, FFN, 0.5f, getp()->in[second ? 43 : 4] + l * 1024, getp()->in[second ? 44 : 5] + l * 1024, j == 7 ? getp()->out : (float*)nullptr, l * 4 + (second ? 3 : 0));
    if (!second) convert_mix(getp(), l);
    else if (l < 3) convert_ffn(getp(), getp()->in[2] + (long)(l + 1) * 1024 * 2 * FFN, getp()->in[3] + (long)(l + 1) * FFN * 1024, getp()->wbin, getp()->wbout);
    gbar();
    if (!second) {
      phase_mix_a(getp());
      gbar();
      phase_mixers(getp(), l, l);
      gbar();
      phase_s5_glu(getp(), l);
      gbar();
      phase_merge(getp());
      gbar();
      phase_resid_ln(getp(), getp()->cu, 1024, getp()->wout, 1024, 1.0f, getp()->in[32] + l * 1024, getp()->in[33] + l * 1024, (float*)nullptr, l * 4 + 1);
      convert_cross(getp(), l);
      gbar();
      phase_plain(getp()->x16, 1024, getp()->wq, 1024, getp()->aq, 512, 128, 2);
      gbar();
      phase_cross_attn(getp(), l);
      gbar();
      phase_resid_ln(getp(), getp()->dq, 512, getp()->wo, 512, 1.0f, getp()->in[39] + l * 1024, getp()->in[40] + l * 1024, (float*)nullptr, l * 4 + 2);
      convert_ffn(getp(), getp()->in[41] + (long)l * 1024 * 2 * FFN, getp()->in[42] + (long)l * FFN * 1024, getp()->w1in, getp()->w1out);
      gbar();
    }
  }
}

extern "C" void kernel_launch(void* const* d_in, const int* in_sizes, int n_in, void* d_out, int out_size, void* d_ws, size_t ws_size, hipStream_t stream) {
  Params p; memset(&p, 0, sizeof(p));
  for (int i = 0; i < 45; ++i) p.in[i] = (const float*)d_in[i];
  p.out = (float*)d_out;
  char* base = (char*)d_ws; size_t off = 0;
  auto carve = [&](size_t halves) { hf* r = (hf*)(base + off); off += (halves * 2 + 255) & ~(size_t)255; return r; };
  p.counters = (unsigned*)base; off = 32768;
  p.x16 = carve((size_t)NTOK * 1024);
  p.w1in = carve((size_t)5632 * 1024); p.w1out = carve((size_t)1024 * FFN);
  p.wbin = carve((size_t)5632 * 1024); p.wbout = carve((size_t)1024 * FFN);
  p.wmix = carve((size_t)7936 * 1024);
  p.pswa = carve(1024 * 512); p.ps5 = carve(1024 * 512); p.pconv = carve(1024 * 512); p.pdiff = carve(1024 * 512);
  p.glu = carve(512 * 512); p.wout = carve(1024 * 1024); p.wq = carve(512 * 1024); p.wo = carve(1024 * 512);
  p.wkv = carve((size_t)4 * 1024 * 1024); p.kvc = carve((size_t)4 * 4096 * 1024); p.memn = carve((size_t)4096 * 1024);
  p.aq = carve((size_t)NTOK * 512); p.akv = carve((size_t)NTOK * 256); p.dq = carve((size_t)NTOK * 512);
  p.dk = carve((size_t)NTOK * 512); p.dv = carve((size_t)NTOK * 512); p.su = carve((size_t)NTOK * 512); p.cu = carve((size_t)NTOK * 1024);
  p.s5tmp = carve((size_t)NTOK * 512); p.convout = carve((size_t)NTOK * 512);
  p.swo = carve((size_t)NTOK * 512); p.dfo = carve((size_t)NTOK * 512);
  p.xstat = (unsigned long long*)carve((size_t)NTOK * 4 * 4);
  static int grid_blocks = 0;
  if (!grid_blocks) {
    hipFuncSetAttribute((const void*)fwd_megakernel, hipFuncAttributeMaxDynamicSharedMemorySize, LDS_BYTES);
    int dev = 0, cus = 0, per_cu = 0;
    hipGetDevice(&dev);
    hipDeviceGetAttribute(&cus, hipDeviceAttributeMultiprocessorCount, dev);
    hipOccupancyMaxActiveBlocksPerMultiprocessor(&per_cu, fwd_megakernel, 512, LDS_BYTES);
    if (per_cu > 1) per_cu = 1;
    grid_blocks = cus * per_cu;
    if (grid_blocks <= 0) grid_blocks = 256;
  }
  (void)hipMemsetAsync(d_ws, 0, 32768, stream);
  void* args[] = {&p};
  hipError_t e = hipLaunchCooperativeKernel((const void*)fwd_megakernel, dim3(grid_blocks), dim3(512), args, LDS_BYTES, stream);
  if (e != hipSuccess) fprintf(stderr, "cooperative launch failed: %s (grid %d)\n", hipGetErrorString(e), grid_blocks);
}
```

```cpp
#include <hip/hip_runtime.h>
#include <hip/hip_cooperative_groups.h>
#include <cstdio>
#include <cstring>
namespace cg = cooperative_groups;

typedef _Float16 hf;
typedef _Float16 h8 __attribute__((ext_vector_type(8)));
typedef _Float16 h4 __attribute__((ext_vector_type(4)));
typedef short s4v __attribute__((ext_vector_type(4)));
typedef float f4 __attribute__((ext_vector_type(4)));

constexpr int NTOK = 32768, SEQ = 2048, FFN = 2816;
constexpr int LDS_BYTES = 140 * 1024;
constexpr int CTL_OFF = 136 * 1024;
constexpr float LOG2E = 1.4426950408889634f;
constexpr float DN_ALPHA = 1.681792830507429f;

struct Params {
  const float* in[45];
  float* out;
  hf *x16, *w1in, *w1out, *wbin, *wbout, *wmix, *pswa, *ps5, *pconv, *pdiff, *glu, *wout, *wq, *wo, *wkv, *kvc, *memn;
  hf *aq, *akv, *dq, *dk, *dv, *su, *cu, *s5tmp, *convout, *swo, *dfo;
  unsigned long long* xstat;
  unsigned* counters;
  unsigned pad_;
  unsigned pad2_;
};

extern __shared__ __attribute__((aligned(16))) unsigned char smem[];
__device__ __forceinline__ int tidx() { int t = __builtin_amdgcn_workitem_id_x(); asm volatile("" : "+v"(t)); return t; }
typedef const __attribute__((address_space(4))) Params* KP;
__device__ __forceinline__ KP getp() {
  volatile __attribute__((address_space(3))) unsigned* s = (volatile __attribute__((address_space(3))) unsigned*)(smem + 136 * 1024 + 16);
  const unsigned lo = __builtin_amdgcn_readfirstlane(s[0]), hi = __builtin_amdgcn_readfirstlane(s[1]);
  unsigned long long v = ((unsigned long long)hi << 32) | lo;
  asm volatile("" : "+s"(v));
  return (KP)v;
}

#define XB_TMO      128
#define XB_XCNT(j)  (256  + 64 * (j))
#define XB_XSUB(j)  (1280 + 64 * (j))
#define XB_XGEN(j)  (2304 + 64 * (j))
#define XB_TOP      3328
#define XB_TOPGEN   3392
#define XB_SPIN_CAP (1u << 20)
__device__ __forceinline__ unsigned xb_ld(unsigned* p)              { return __hip_atomic_load(p, __ATOMIC_RELAXED, __HIP_MEMORY_SCOPE_AGENT); }
__device__ __forceinline__ unsigned xb_add(unsigned* p, unsigned v) { return __hip_atomic_fetch_add(p, v, __ATOMIC_RELAXED, __HIP_MEMORY_SCOPE_AGENT); }
__device__ __forceinline__ unsigned xb_xcc_id() { return (unsigned)__builtin_amdgcn_s_getreg((3 << 11) | 20) & 0xFu; }
#define XB_SPIN(cond, bar) do { unsigned _sp = 0; while (cond) { __builtin_amdgcn_s_sleep(1); \
    if ((++_sp & 255u) == 0u) { if (xb_ld(&(bar)[XB_TMO])) break; if (_sp > XB_SPIN_CAP) { atomicAdd(&(bar)[XB_TMO], 1u); break; } } } } while (0)
__device__ __forceinline__ void xcd_barrier_complete(unsigned* bar, unsigned x, unsigned& nloc, unsigned& nx) {
  const unsigned G = gridDim.x;
  unsigned sum, cnt, mine, sp = 0u;
  for (;;) {
    sum = 0u; cnt = 0u; mine = 0u;
#pragma unroll
    for (unsigned j = 0; j < 16; ++j) { const unsigned c = xb_ld(&bar[XB_XCNT(j)]); sum += c; cnt += (c > 0u) ? 1u : 0u; mine = (j == x) ? c : mine; }
    if (sum == G) break;
    __builtin_amdgcn_s_sleep(1);
    if ((++sp & 255u) == 0u) { if (xb_ld(&bar[XB_TMO])) break; if (sp > XB_SPIN_CAP) { atomicAdd(&bar[XB_TMO], 1u); break; } }
  }
  nloc = mine > 0u ? mine : 1u; nx = cnt > 0u ? cnt : 1u;
}
__device__ __forceinline__ void gbar() {
  asm volatile("s_waitcnt vmcnt(0)" ::: "memory");
  __syncthreads();
  if (tidx() == 0) {
    unsigned* bar = getp()->counters;
    volatile __attribute__((address_space(3))) unsigned* st = (volatile __attribute__((address_space(3))) unsigned*)(smem + 136 * 1024 + 32);
    const unsigned x = xb_xcc_id();
    __builtin_amdgcn_s_waitcnt(0);
    unsigned nloc = st[0], nx = st[1];
    if (nloc == 0u) { xcd_barrier_complete(bar, x, nloc, nx); st[0] = nloc; st[1] = nx; }
    const unsigned old = xb_add(&bar[XB_XSUB(x)], 1u);
    const unsigned gen = old / nloc;
    if (old + 1u == (gen + 1u) * nloc) {
      __builtin_amdgcn_fence(__ATOMIC_RELEASE, "agent");
      asm volatile("s_waitcnt vmcnt(0)" ::: "memory");
      const unsigned og = xb_add(&bar[XB_TOP], 1u);
      const unsigned tg = og / nx;
      if (og + 1u == (tg + 1u) * nx) xb_add(&bar[XB_TOPGEN], 1u);
      else XB_SPIN(xb_ld(&bar[XB_TOPGEN]) == tg, bar);
      __builtin_amdgcn_fence(__ATOMIC_ACQUIRE, "agent");
      xb_add(&bar[XB_XGEN(x)], 1u);
      asm volatile("s_waitcnt vmcnt(0)" ::: "memory");
    } else {
      XB_SPIN(xb_ld(&bar[XB_XGEN(x)]) == gen, bar);
      __builtin_amdgcn_fence(__ATOMIC_ACQUIRE, "agent");
      asm volatile("s_waitcnt vmcnt(0)" ::: "memory");
    }
  }
  __syncthreads();
}

constexpr int BM = 256, BK = 64, HALFT = 128, HT = HALFT * BK;
__device__ __forceinline__ int lds_byte(int r, int c) {
  int st = (r >> 4) * 2 + (c >> 5), rr = r & 15, cc = c & 31, ob = rr * 64 + cc * 2;
  return st * 1024 + (ob ^ (((ob >> 9) & 1) << 5));
}
__device__ __forceinline__ void stage_rc(int b, int& R, int& C) {
  int st = b / 1024, sb = b % 1024, swz = sb ^ (((sb >> 9) & 1) << 5);
  R = (st >> 1) * 16 + swz / 64; C = (st & 1) * 32 + (swz % 64) / 2;
}
__device__ __forceinline__ bool tile_order(int i, int nM, int nN, int& pm, int& pn) {
  const int nwg = nM * nN; const int L = i * (int)gridDim.x + (int)blockIdx.x; if (L >= nwg) return false;
  int wgid = (int)L; { const int q = nwg / 8, r = nwg % 8, xcd = wgid % 8, off = wgid / 8; wgid = (xcd < r ? xcd * (q + 1) : r * (q + 1) + (xcd - r) * q) + off; }
  const int nig = 8 * nN, gid = wgid / nig, fm = gid * 8, gsz = (nM - fm) < 8 ? (nM - fm) : 8;
  pm = fm + ((wgid % nig) % gsz); pn = (wgid % nig) / gsz; return true;
}

#define LAS __attribute__((address_space(3)))
constexpr int HTB = HALFT * BK * 2;
struct GU { const char* A; const char* B; int lda, ldb, nt, brow, bcol, aux; };

template <class Prov, class Epi>
__device__ __forceinline__ void gemm_stream(Prov prov, Epi epi) {
  LAS unsigned char* lds = (LAS unsigned char*)smem;
  const int tid = tidx();
  const int wid = __builtin_amdgcn_readfirstlane(tid >> 6), lane = tid & 63, wr = wid >> 2, wc = wid & 3, fr = lane & 15, fq = lane >> 4;
  int sR[2], sC[2];
#pragma unroll
  for (int i = 0; i < 2; ++i) stage_rc(tid * 16 + i * 8192, sR[i], sC[i]);
  const size_t kstep = (size_t)(BK * 2);
  const unsigned ldsw = (unsigned)wid * 1024u;
  const int aoff = lds_byte(wr * 64 + fr, fq * 8), boff = lds_byte(wc * 32 + fr, fq * 8);
  GU cur, nxt;
  if (!prov(0, cur)) return;
  int ui = 0;
#define GSA(b, h) (((b)*2 + (h)) * HTB)
#define GSB(b, h) ((4 + (b)*2 + (h)) * HTB)
#define STAGE(bufoff, gbase, ld) do { _Pragma("unroll") for (int _i = 0; _i < 2; ++_i) \
    __builtin_amdgcn_global_load_lds((const unsigned*)((const char*)(gbase) + (unsigned)((sR[_i] * (ld) + sC[_i]) * 2)), (LAS unsigned*)(lds + (bufoff) + ldsw + _i * 8192), 16, 0, 0); } while (0)
#define LDA(dst, b, h) do { _Pragma("unroll") for (int m = 0; m < 4; ++m) _Pragma("unroll") for (int k = 0; k < 2; ++k) dst[m][k] = *(const LAS h8*)(lds + GSA(b, h) + aoff + m * 2048 + k * 1024); } while (0)
#define LDB(dst, b, h) do { _Pragma("unroll") for (int n = 0; n < 2; ++n) _Pragma("unroll") for (int k = 0; k < 2; ++k) dst[n][k] = *(const LAS h8*)(lds + GSB(b, h) + boff + n * 2048 + k * 1024); } while (0)
#define MMA(ai, bj, At_, Bt_) do { __builtin_amdgcn_s_setprio(1); _Pragma("unroll") for (int m = 0; m < 4; ++m) _Pragma("unroll") for (int n = 0; n < 2; ++n) _Pragma("unroll") for (int k = 0; k < 2; ++k) \
      acc[ai][bj][m][n] = __builtin_amdgcn_mfma_f32_16x16x32_f16(Bt_[n][k], At_[m][k], acc[ai][bj][m][n], 0, 0, 0); \
    __builtin_amdgcn_s_setprio(0); } while (0)
#define WAIT_V(n) asm volatile("s_waitcnt vmcnt(" #n ")" ::: "memory")
#define WAIT_L(n) asm volatile("s_waitcnt lgkmcnt(" #n ")" ::: "memory")
#define BAR __builtin_amdgcn_s_barrier()
#define SCHED __builtin_amdgcn_sched_barrier(0)
#define ZERO_ACC _Pragma("unroll") for (int a = 0; a < 2; ++a) _Pragma("unroll") for (int b = 0; b < 2; ++b) _Pragma("unroll") for (int m = 0; m < 4; ++m) _Pragma("unroll") for (int n = 0; n < 2; ++n) acc[a][b][m][n] = (f4){0.f, 0.f, 0.f, 0.f}
  f4 acc[2][2][4][2];
  ZERO_ACC;
  h8 At[4][2], B0[2][2], B1[2][2];
  { const size_t hA = (size_t)HALFT * cur.lda * 2, hB = (size_t)HALFT * cur.ldb * 2;
    STAGE(GSB(0, 0), cur.B, cur.ldb); STAGE(GSB(0, 1), cur.B + hB, cur.ldb); STAGE(GSA(0, 0), cur.A, cur.lda); STAGE(GSA(0, 1), cur.A + hA, cur.lda);
    if (wr == 1) BAR;
    WAIT_V(2); BAR;
    STAGE(GSB(1, 0), cur.B + kstep, cur.ldb); STAGE(GSA(1, 0), cur.A + kstep, cur.lda); STAGE(GSB(1, 1), cur.B + hB + kstep, cur.ldb);
    WAIT_V(6); BAR; }
#pragma unroll 1
  for (;;) {
    const bool has_next = prov(ui + 1, nxt);
    if (!has_next) nxt = cur;
    const int nt = cur.nt;
    const size_t hA = (size_t)HALFT * cur.lda * 2;
#pragma unroll 1
    for (int t = 0; t < nt; t += 2) {
      const bool last = (t + 2 >= nt);
      const char* a1 = cur.A + (size_t)(t + 1) * kstep + hA;
      const char* a2 = last ? nxt.A : cur.A + (size_t)(t + 2) * kstep;
      const char* b2 = last ? nxt.B : cur.B + (size_t)(t + 2) * kstep;
      const int lda2 = last ? nxt.lda : cur.lda, ldb2 = last ? nxt.ldb : cur.ldb;
      const size_t hA2 = (size_t)HALFT * lda2 * 2, hB2 = (size_t)HALFT * ldb2 * 2;
      LDB(B0, 0, 0); LDB(B1, 0, 1); SCHED; LDA(At, 0, 0); STAGE(GSA(1, 1), a1, cur.lda);
      WAIT_V(8); WAIT_L(0); BAR; MMA(0, 0, At, B0); MMA(0, 1, At, B1); BAR; SCHED;
      LDA(At, 0, 1); STAGE(GSB(0, 0), b2, ldb2); STAGE(GSB(0, 1), b2 + hB2, ldb2); STAGE(GSA(0, 0), a2, lda2);
      WAIT_V(8); WAIT_L(0); BAR; MMA(1, 0, At, B0); MMA(1, 1, At, B1); BAR; SCHED;
      LDB(B0, 1, 0); LDB(B1, 1, 1); SCHED; LDA(At, 1, 0); STAGE(GSA(0, 1), a2 + hA2, lda2);
      WAIT_V(8); WAIT_L(0); BAR; MMA(0, 0, At, B0); MMA(0, 1, At, B1); BAR; SCHED;
      LDA(At, 1, 1); STAGE(GSB(1, 0), b2 + kstep, ldb2); STAGE(GSB(1, 1), b2 + hB2 + kstep, ldb2); STAGE(GSA(1, 0), a2 + kstep, lda2);
      WAIT_V(8); WAIT_L(0); BAR; MMA(1, 0, At, B0); MMA(1, 1, At, B1); BAR; SCHED;
    }
    if (wr == 0) BAR;
    epi(acc, cur, wr, wc, fr, fq);
    ZERO_ACC;
    if (!has_next) break;
    cur = nxt; ++ui;
    if (wr == 1) BAR;
  }
  asm volatile("s_waitcnt vmcnt(0)" ::: "memory");
  __syncthreads();
#undef GSA
#undef GSB
#undef STAGE
#undef LDA
#undef LDB
#undef MMA
#undef ZERO_ACC
}

#define EPI_ARGS f4 (&acc)[2][2][4][2], const GU& d, int wr, int wc, int fr, int fq
#define EPI_ROWS _Pragma("unroll") for (int ai = 0; ai < 2; ++ai) _Pragma("unroll") for (int m = 0; m < 4; ++m)
#define EPI_COLS _Pragma("unroll") for (int bj = 0; bj < 2; ++bj) _Pragma("unroll") for (int n = 0; n < 2; ++n)
#define AINL __attribute__((always_inline))

__device__ __forceinline__ float sigmoidf_(float x) { return __builtin_amdgcn_rcpf(1.0f + __builtin_amdgcn_exp2f(-1.4426950408889634f * x)); }
__device__ __forceinline__ h4 cvt4(f4 v) { h4 r; r[0] = (hf)v[0]; r[1] = (hf)v[1]; r[2] = (hf)v[2]; r[3] = (hf)v[3]; return r; }
__device__ __forceinline__ h8 cvt8(f4 a, f4 b) { h8 r; r[0] = (hf)a[0]; r[1] = (hf)a[1]; r[2] = (hf)a[2]; r[3] = (hf)a[3]; r[4] = (hf)b[0]; r[5] = (hf)b[1]; r[6] = (hf)b[2]; r[7] = (hf)b[3]; return r; }
#define EPI_BJ _Pragma("unroll") for (int bj = 0; bj < 2; ++bj)
__device__ __forceinline__ void set_gu(GU& d, const hf* A, int lda, const hf* B, int ldb, int K, int brow, int bcol, int aux) {
  d.A = (const char*)(A + (size_t)brow * lda); d.B = (const char*)(B + (size_t)bcol * ldb); d.lda = lda; d.ldb = ldb; d.nt = K / BK; d.brow = brow; d.bcol = bcol; d.aux = aux;
}

__device__ __forceinline__ void phase_ffn_a(KP p, const hf* w_in, bool with_kv) {
  hf* hidden = p->aq; hf* kvc = p->kvc;
  const hf* x16 = p->x16; const hf* memn = p->memn; const hf* wkv = p->wkv;
  const int nA = 128 * 22, total = nA + (with_kv ? 256 : 0);
  gemm_stream([&](int i, GU& d) AINL -> bool {
      const int L = i * (int)gridDim.x + (int)blockIdx.x; if (L >= total) return false;
      if (L < nA) {
        int wgid = (int)L; const int q = nA / 8, off = wgid / 8, xcd = wgid % 8; wgid = xcd * q + off;
        const int nig = 8 * 22, gid = wgid / nig, fm = gid * 8, pm = fm + ((wgid % nig) % 8), pn = (wgid % nig) / 8;
        set_gu(d, x16, 1024, w_in, 1024, 1024, pm * 256, pn * 256, 0);
      } else {
        const int t = (int)L - nA, l = t >> 6, pm = (t & 63) >> 2, pn = t & 3;
        set_gu(d, memn, 1024, wkv + (size_t)l * 1024 * 1024, 1024, 1024, pm * 256, pn * 256, 1 + l);
      }
      return true; },
    [&](EPI_ARGS) AINL {
      if (d.aux == 0) {
        EPI_ROWS { const long row = d.brow + ai * 128 + wr * 64 + m * 16 + fr;
          f4 v[2];
          _Pragma("unroll") for (int n = 0; n < 2; ++n) { const f4 g = acc[ai][0][m][n], u = acc[ai][1][m][n];
            _Pragma("unroll") for (int j = 0; j < 4; ++j) v[n][j] = g[j] * sigmoidf_(g[j]) * u[j]; }
          *(h8*)(hidden + row * FFN + (d.bcol >> 1) + wc * 32 + fq * 8) = cvt8(v[0], v[1]); }
      } else {
        hf* dst = kvc + (size_t)(d.aux - 1) * 4096 * 1024;
        EPI_ROWS { const long row = d.brow + ai * 128 + wr * 64 + m * 16 + fr;
          EPI_BJ { *(h8*)(dst + row * 1024 + d.bcol + bj * 128 + wc * 32 + fq * 8) = cvt8(acc[ai][bj][m][0], acc[ai][bj][m][1]); } }
      } });
}

__device__ __forceinline__ void phase_resid(KP p, const hf* A, int lda, const hf* Wt, int K, float scale) {
  hf* y16 = p->s5tmp; const hf* res = p->x16;
  gemm_stream([&](int i, GU& d) AINL -> bool { int pm, pn; if (!tile_order(i, 128, 4, pm, pn)) return false; set_gu(d, A, lda, Wt, K, K, pm * 256, pn * 256, 0); return true; },
    [&](EPI_ARGS) AINL {
      EPI_ROWS { const long row = d.brow + ai * 128 + wr * 64 + m * 16 + fr;
        EPI_BJ { const long o = row * 1024 + d.bcol + bj * 128 + wc * 32 + fq * 8;
          const h8 r = *(const h8*)(res + o); f4 v0 = acc[ai][bj][m][0], v1 = acc[ai][bj][m][1];
          _Pragma("unroll") for (int j = 0; j < 4; ++j) { v0[j] = DN_ALPHA * (float)r[j] + scale * v0[j]; v1[j] = DN_ALPHA * (float)r[4 + j] + scale * v1[j]; }
          *(h8*)(y16 + o) = cvt8(v0, v1); } } });
}

__device__ __forceinline__ void phase_resid_ln(KP p, const hf* A, int lda, const hf* Wt, int K, float scale, const float* lng, const float* lnb, float* out32, int seq) {
  hf* x16 = p->x16; unsigned long long* xs = p->xstat; unsigned* pcnt = p->counters + 4096;
  gemm_stream([&](int i, GU& d) AINL -> bool { int pm, pn; if (!tile_order(i, 128, 4, pm, pn)) return false; set_gu(d, A, lda, Wt, K, K, pm * 256, pn * 256, pn); return true; },
    [&](EPI_ARGS) AINL {
      LAS float* P = (LAS float*)((LAS unsigned char*)smem + 131072);
      const int tid = tidx();
      EPI_ROWS { const int rl = ai * 128 + wr * 64 + m * 16 + fr; const long row = d.brow + rl; float s = 0.f, q = 0.f;
        EPI_BJ { const long o = row * 1024 + d.bcol + bj * 128 + wc * 32 + fq * 8; const h8 r = *(const h8*)(x16 + o);
          _Pragma("unroll") for (int j = 0; j < 4; ++j) { const float a0 = DN_ALPHA * (float)r[j] + scale * acc[ai][bj][m][0][j], a1 = DN_ALPHA * (float)r[4 + j] + scale * acc[ai][bj][m][1][j];
            acc[ai][bj][m][0][j] = a0; acc[ai][bj][m][1][j] = a1; s += a0 + a1; q += a0 * a0 + a1 * a1; } }
        s += __shfl_xor(s, 16); s += __shfl_xor(s, 32); q += __shfl_xor(q, 16); q += __shfl_xor(q, 32);
        if (fq == 0) { P[(rl * 4 + wc) * 2] = s; P[(rl * 4 + wc) * 2 + 1] = q; } }
      __syncthreads();
      if (tid < 256) { float s = 0.f, q = 0.f; _Pragma("unroll") for (int w4 = 0; w4 < 4; ++w4) { s += P[(tid * 4 + w4) * 2]; q += P[(tid * 4 + w4) * 2 + 1]; }
        const unsigned long long v = ((unsigned long long)__float_as_uint(q) << 32) | __float_as_uint(s);
        __hip_atomic_store(xs + (long)(d.brow + tid) * 4 + d.aux, v, __ATOMIC_RELAXED, __HIP_MEMORY_SCOPE_AGENT); }
      asm volatile("s_waitcnt vmcnt(0)" ::: "memory");
      __syncthreads();
      if (tid == 0) { unsigned* c = pcnt + (d.brow >> 8) * 16; __hip_atomic_fetch_add(c, 1u, __ATOMIC_RELAXED, __HIP_MEMORY_SCOPE_AGENT);
        const unsigned target = 4u * (unsigned)(seq + 1); unsigned sp = 0;
        while (__hip_atomic_load(c, __ATOMIC_RELAXED, __HIP_MEMORY_SCOPE_AGENT) < target) { __builtin_amdgcn_s_sleep(1); if (++sp > (1u << 22)) break; } }
      asm volatile("s_waitcnt vmcnt(0)" ::: "memory");
      __syncthreads();
      if (tid < 256) { float s = 0.f, q = 0.f;
        _Pragma("unroll") for (int pn = 0; pn < 4; ++pn) { const unsigned long long v = __hip_atomic_load(xs + (long)(d.brow + tid) * 4 + pn, __ATOMIC_RELAXED, __HIP_MEMORY_SCOPE_AGENT);
          s += __uint_as_float((unsigned)v); q += __uint_as_float((unsigned)(v >> 32)); }
        const float mu = s * (1.0f / 1024.0f), var = q * (1.0f / 1024.0f) - mu * mu;
        P[tid * 2] = mu; P[tid * 2 + 1] = rsqrtf(var + 1e-5f); }
      __syncthreads();
      EPI_ROWS { const int rl = ai * 128 + wr * 64 + m * 16 + fr; const long row = d.brow + rl; const float mu = P[rl * 2], rs = P[rl * 2 + 1];
        EPI_BJ { const int col = d.bcol + bj * 128 + wc * 32 + fq * 8; const long o = row * 1024 + col;
          const f4 g0 = *(const f4*)(lng + col), g1 = *(const f4*)(lng + col + 4), b0 = *(const f4*)(lnb + col), b1 = *(const f4*)(lnb + col + 4); f4 v0, v1;
          _Pragma("unroll") for (int j = 0; j < 4; ++j) { v0[j] = (acc[ai][bj][m][0][j] - mu) * rs * g0[j] + b0[j]; v1[j] = (acc[ai][bj][m][1][j] - mu) * rs * g1[j] + b1[j]; }
          *(h8*)(x16 + o) = cvt8(v0, v1);
          if (out32) { *(f4*)(out32 + o) = v0; *(f4*)(out32 + o + 4) = v1; } } }
      __syncthreads();
    });
}

__device__ __forceinline__ void phase_mix_a(KP p) {
  gemm_stream([&](int i, GU& d) AINL -> bool { int pm, pn; if (!tile_order(i, 128, 15, pm, pn)) return false; KP q = getp(); set_gu(d, q->x16, 1024, q->wmix, 1024, 1024, pm * 256, pn * 256, pn); return true; },
    [&](EPI_ARGS) AINL {
      const int pn = d.aux; hf* dst; int ldc, coff; KP q = getp();
      if (pn < 2) { dst = q->aq; ldc = 512; coff = pn * 256; }
      else if (pn == 2) { dst = q->akv; ldc = 256; coff = 0; }
      else if (pn < 5) { dst = q->dq; ldc = 512; coff = (pn - 3) * 256; }
      else if (pn < 7) { dst = q->dk; ldc = 512; coff = (pn - 5) * 256; }
      else if (pn < 9) { dst = q->dv; ldc = 512; coff = (pn - 7) * 256; }
      else if (pn < 11) { dst = q->su; ldc = 512; coff = (pn - 9) * 256; }
      else { dst = q->cu; ldc = 1024; coff = (pn - 11) * 256; }
      EPI_ROWS { const long row = d.brow + ai * 128 + wr * 64 + m * 16 + fr;
        EPI_BJ { *(h8*)(dst + row * ldc + coff + bj * 128 + wc * 32 + fq * 8) = cvt8(acc[ai][bj][m][0], acc[ai][bj][m][1]); } } });
}

__device__ __forceinline__ void phase_plain(const hf* A, int lda, const hf* Wt, int K, hf* dst, int ldc, int nM, int nN) {
  gemm_stream([&](int i, GU& d) AINL -> bool { int pm, pn; if (!tile_order(i, nM, nN, pm, pn)) return false; set_gu(d, A, lda, Wt, K, K, pm * 256, pn * 256, 0); return true; },
    [&](EPI_ARGS) AINL {
      EPI_ROWS { const long row = d.brow + ai * 128 + wr * 64 + m * 16 + fr;
        EPI_BJ { *(h8*)(dst + row * ldc + d.bcol + bj * 128 + wc * 32 + fq * 8) = cvt8(acc[ai][bj][m][0], acc[ai][bj][m][1]); } } });
}

__device__ __forceinline__ void phase_s5_glu(KP p, int l) {
  const float* gb = p->in[18] + l * 512; const hf* y = p->s5tmp; hf* dst = p->su; const hf* glu = p->glu;
  gemm_stream([&](int i, GU& d) AINL -> bool { int pm, pn; if (!tile_order(i, 128, 2, pm, pn)) return false; set_gu(d, y, 512, glu, 512, 512, pm * 256, pn * 256, 0); return true; },
    [&](EPI_ARGS) AINL {
      EPI_ROWS { const long row = d.brow + ai * 128 + wr * 64 + m * 16 + fr;
        EPI_BJ { const int col = d.bcol + bj * 128 + wc * 32 + fq * 8;
          const h8 yy = *(const h8*)(y + row * 512 + col); const f4 b0 = *(const f4*)(gb + col), b1 = *(const f4*)(gb + col + 4); f4 v0 = acc[ai][bj][m][0], v1 = acc[ai][bj][m][1];
          _Pragma("unroll") for (int j = 0; j < 4; ++j) { v0[j] = (float)yy[j] * sigmoidf_(v0[j] + b0[j]); v1[j] = (float)yy[4 + j] * sigmoidf_(v1[j] + b1[j]); }
          *(h8*)(dst + row * 512 + col) = cvt8(v0, v1); } } });
}

__device__ __forceinline__ void phase_merge(KP p) {
  gemm_stream([&](int idx, GU& d) AINL -> bool {
      const int it = idx >> 3, s = idx & 7, i = s >> 1; int pm, pn; if (!tile_order(it, 128, 4, pm, pn)) return false;
      KP q = getp();
      if ((s & 1) == 0) set_gu(d, q->x16, 1024, q->wmix + (size_t)(3840 + i * 1024) * 1024, 1024, 1024, pm * 256, pn * 256, s);
      else { const hf* A = i == 0 ? q->swo : i == 1 ? q->su : i == 2 ? q->convout : q->dfo; const hf* W = i == 0 ? q->pswa : i == 1 ? q->ps5 : i == 2 ? q->pconv : q->pdiff;
        set_gu(d, A, 512, W, 512, 512, pm * 256, pn * 256, s); }
      return true; },
    [&](EPI_ARGS) AINL {
      const int s = d.aux; KP q = getp(); hf* gbuf = q->dk; hf* merged = q->cu;
      if ((s & 1) == 0) {
        EPI_ROWS { const long row = d.brow + ai * 128 + wr * 64 + m * 16 + fr;
          EPI_BJ { f4 v0 = acc[ai][bj][m][0], v1 = acc[ai][bj][m][1]; _Pragma("unroll") for (int j = 0; j < 4; ++j) { v0[j] = sigmoidf_(v0[j]); v1[j] = sigmoidf_(v1[j]); }
            *(h8*)(gbuf + row * 1024 + d.bcol + bj * 128 + wc * 32 + fq * 8) = cvt8(v0, v1); } }
      } else {
        EPI_ROWS { const long row = d.brow + ai * 128 + wr * 64 + m * 16 + fr;
          EPI_BJ { const long o = row * 1024 + d.bcol + bj * 128 + wc * 32 + fq * 8;
            const h8 g = *(const h8*)(gbuf + o); f4 v0 = acc[ai][bj][m][0], v1 = acc[ai][bj][m][1];
            _Pragma("unroll") for (int j = 0; j < 4; ++j) { v0[j] *= (float)g[j]; v1[j] *= (float)g[4 + j]; }
            if (s > 1) { const h8 mo = *(const h8*)(merged + o); _Pragma("unroll") for (int j = 0; j < 4; ++j) { v0[j] += (float)mo[j]; v1[j] += (float)mo[4 + j]; } }
            *(h8*)(merged + o) = cvt8(v0, v1); } }
      } });
}

__device__ __forceinline__ float wave_sum(float v) {
  for (int o = 32; o > 0; o >>= 1) v += __shfl_xor(v, o);
  return v;
}

__device__ __forceinline__ void ln_rows(const float* src, const float* g, const float* b, float* dst32, hf* dst16, int nrows) {
  const int wave = blockIdx.x * 8 + (tidx() >> 6), nw = gridDim.x * 8, lane = tidx() & 63;
  f4 gg[4], bb[4];
  for (int i = 0; i < 4; ++i) { gg[i] = *(const f4*)(g + i * 256 + lane * 4); bb[i] = *(const f4*)(b + i * 256 + lane * 4); }
  for (int r = wave; r < nrows; r += nw) {
    f4 v[4]; float s = 0.f;
    for (int i = 0; i < 4; ++i) { v[i] = *(const f4*)(src + (long)r * 1024 + i * 256 + lane * 4); s += (v[i][0] + v[i][1]) + (v[i][2] + v[i][3]); }
    const float mu = wave_sum(s) * (1.0f / 1024.0f);
    float q = 0.f;
    for (int i = 0; i < 4; ++i) for (int j = 0; j < 4; ++j) { const float d = v[i][j] - mu; q += d * d; }
    const float rs = rsqrtf(wave_sum(q) * (1.0f / 1024.0f) + 1e-5f);
    for (int i = 0; i < 4; ++i) { f4 o; for (int j = 0; j < 4; ++j) o[j] = (v[i][j] - mu) * rs * gg[i][j] + bb[i][j];
      if (dst32) *(f4*)(dst32 + (long)r * 1024 + i * 256 + lane * 4) = o;
      *(h4*)(dst16 + (long)r * 1024 + i * 256 + lane * 4) = cvt4(o); }
  }
}

__device__ __forceinline__ void ln_rows16(const hf* src, const float* g, const float* b, float* dst32, hf* dst16, int nrows) {
  const int wave = blockIdx.x * 8 + (tidx() >> 6), nw = gridDim.x * 8, lane = tidx() & 63;
  f4 gg[4], bb[4];
  for (int i = 0; i < 4; ++i) { gg[i] = *(const f4*)(g + i * 256 + lane * 4); bb[i] = *(const f4*)(b + i * 256 + lane * 4); }
  for (int r = wave; r < nrows; r += nw) {
    f4 v[4]; float s = 0.f;
    for (int i = 0; i < 4; ++i) { const h4 t = *(const h4*)(src + (long)r * 1024 + i * 256 + lane * 4); v[i][0] = (float)t[0]; v[i][1] = (float)t[1]; v[i][2] = (float)t[2]; v[i][3] = (float)t[3];
      s += (v[i][0] + v[i][1]) + (v[i][2] + v[i][3]); }
    const float mu = wave_sum(s) * (1.0f / 1024.0f);
    float q = 0.f;
    for (int i = 0; i < 4; ++i) for (int j = 0; j < 4; ++j) { const float d = v[i][j] - mu; q += d * d; }
    const float rs = rsqrtf(wave_sum(q) * (1.0f / 1024.0f) + 1e-5f);
    for (int i = 0; i < 4; ++i) { f4 o; for (int j = 0; j < 4; ++j) o[j] = (v[i][j] - mu) * rs * gg[i][j] + bb[i][j];
      if (dst32) *(f4*)(dst32 + (long)r * 1024 + i * 256 + lane * 4) = o;
      *(h4*)(dst16 + (long)r * 1024 + i * 256 + lane * 4) = cvt4(o); }
  }
}

__device__ __forceinline__ void conv_w_job(const float* __restrict__ src, int ld, int K, hf* __restrict__ dst, int NBk  , int mode, int coloff) {
  float* tile = (float*)smem;
  const int nkb = K / 64, total = NBk * nkb, tid = tidx();
  for (int u = blockIdx.x; u < total; u += gridDim.x) {
    const int nb = u / nkb, kb = u % nkb;
    int c0;
    if (mode == 0) c0 = coloff + nb * 64;
    else { const int j = nb >> 2, sub = nb & 3; c0 = (sub < 2) ? (j * 128 + sub * 64) : (FFN + j * 128 + (sub - 2) * 64); }
    __syncthreads();
    for (int h = 0; h < 2; ++h) { const int kk = (tid >> 4) + h * 32, c4 = tid & 15;
      const f4 v = *(const f4*)(src + (long)(kb * 64 + kk) * ld + c0 + c4 * 4);
      for (int j = 0; j < 4; ++j) tile[kk * 65 + c4 * 4 + j] = v[j]; }
    __syncthreads();
    { const int n = tid >> 3, k8 = tid & 7; h8 o;
      const int rho = n & 31, ii = rho & 15, ns = (n & 32) + 8 * (ii >> 2) + 4 * (rho >> 4) + (ii & 3);
      for (int j = 0; j < 8; ++j) o[j] = (hf)tile[(k8 * 8 + j) * 65 + ns];
      *(h8*)(dst + (long)(nb * 64 + n) * K + kb * 64 + k8 * 8) = o; }
  }
}

__device__ __forceinline__ void convert_ffn(KP p, const float* w_in, const float* w_out, hf* din, hf* dout) {
  conv_w_job(w_in, 2 * FFN, 1024, din, 88, 1, 0);
  conv_w_job(w_out, 1024, FFN, dout, 16, 0, 0);
}
__device__ __forceinline__ void convert_mix(KP p, int l) {
  conv_w_job(p->in[6] + (long)l * 1024 * 7936, 7936, 1024, p->wmix, 124, 0, 0);
  conv_w_job(p->in[8] + (long)l * 512 * 1024, 1024, 512, p->pswa, 16, 0, 0);
  conv_w_job(p->in[19] + (long)l * 512 * 1024, 1024, 512, p->ps5, 16, 0, 0);
  conv_w_job(p->in[24] + (long)l * 512 * 1024, 1024, 512, p->pconv, 16, 0, 0);
  conv_w_job(p->in[30] + (long)l * 512 * 1024, 1024, 512, p->pdiff, 16, 0, 0);
  conv_w_job(p->in[17] + (long)l * 512 * 512, 512, 512, p->glu, 8, 0, 0);
  conv_w_job(p->in[31] + (long)l * 1024 * 1024, 1024, 1024, p->wout, 16, 0, 0);
}
__device__ __forceinline__ void convert_cross(KP p, int l) {
  conv_w_job(p->in[36] + (long)l * 1024 * 512, 512, 1024, p->wq, 8, 0, 0);
  conv_w_job(p->in[38] + (long)l * 512 * 1024, 1024, 512, p->wo, 16, 0, 0);
}

__device__ __forceinline__ void phase_init(KP p) {
  { const long n4 = (long)NTOK * 1024 / 4; const f4* s = (const f4*)p->in[0]; h4* d = (h4*)p->x16;
    for (long i = (long)blockIdx.x * 512 + tidx(); i < n4; i += (long)gridDim.x * 512) d[i] = cvt4(s[i]); }
  ln_rows(p->in[1], p->in[34], p->in[35], nullptr, p->memn, 4096);
  convert_ffn(p, p->in[2], p->in[3], p->wbin, p->wbout);
  for (int l = 0; l < 4; ++l) conv_w_job(p->in[37] + (long)l * 1024 * 1024, 1024, 1024, p->wkv + (long)l * 1024 * 1024, 16, 0, 0);
}

__device__ __forceinline__ h4 trrd(const hf* q) { return __builtin_bit_cast(h4, __builtin_amdgcn_ds_read_tr16_b64_v4i16((__attribute__((address_space(3))) s4v*)q)); }

template <int DK, int DV, int KW, bool ALIBI, int MASK>
__device__ __forceinline__ void attn_core(const hf* __restrict__ Kg, long kstride, const hf* __restrict__ Vg, long vstride, int T0, int T1,
                                          const hf* __restrict__ Qw, long qstride, int kcol, int q0, float c1, float c2,
                                          f4 (&O)[2][DV / 16], float (&m)[2], float (&l)[2]) {
  constexpr int KSTR = KW + 8, VSTR = DV + 8, KCH = KW / 8, VCH = DV / 8, NKL = 64 * KCH / 512, NVL = 64 * VCH / 512;
  hf* Ks = (hf*)smem; hf* Vs = Ks + 64 * KSTR;
  const int tid = tidx(), lane = tid & 63, fr = lane & 15, fq = lane >> 4;
  h8 qf[2][DK / 32];
#pragma unroll
  for (int qs = 0; qs < 2; ++qs)
#pragma unroll
    for (int ks = 0; ks < DK / 32; ++ks) qf[qs][ks] = *(const h8*)(Qw + (long)(qs * 16 + fr) * qstride + ks * 32 + fq * 8);
  h8 kreg[NKL], vreg[NVL];
#pragma unroll
  for (int i = 0; i < NKL; ++i) { const int idx = tid + i * 512, r = idx / KCH, c = idx % KCH; kreg[i] = *(const h8*)(Kg + (long)((T1 - 1) * 64 + r) * kstride + c * 8); }
#pragma unroll
  for (int i = 0; i < NVL; ++i) { const int idx = tid + i * 512, r = idx / VCH, c = idx % VCH; vreg[i] = *(const h8*)(Vg + (long)((T1 - 1) * 64 + r) * vstride + c * 8); }
#pragma unroll 1
  for (int T = T1 - 1; T >= T0; --T) {
    __syncthreads();
#pragma unroll
    for (int i = 0; i < NKL; ++i) { const int idx = tid + i * 512, r = idx / KCH, c = idx % KCH; *(h8*)(Ks + r * KSTR + c * 8) = kreg[i]; }
#pragma unroll
    for (int i = 0; i < NVL; ++i) { const int idx = tid + i * 512, r = idx / VCH, c = idx % VCH; *(h8*)(Vs + r * VSTR + c * 8) = vreg[i]; }
    __syncthreads();
    if (T - 1 >= T0) {
#pragma unroll
      for (int i = 0; i < NKL; ++i) { const int idx = tid + i * 512, r = idx / KCH, c = idx % KCH; kreg[i] = *(const h8*)(Kg + (long)((T - 1) * 64 + r) * kstride + c * 8); }
#pragma unroll
      for (int i = 0; i < NVL; ++i) { const int idx = tid + i * 512, r = idx / VCH, c = idx % VCH; vreg[i] = *(const h8*)(Vg + (long)((T - 1) * 64 + r) * vstride + c * 8); }
    }
    bool rel = true;
    if (MASK >= 1) rel = (T * 64 <= q0 + 31);
    if (MASK == 2) rel = rel && (T * 64 + 63 >= q0 - 127);
    if (rel) {
      f4 S[2][4];
#pragma unroll
      for (int kt = 0; kt < 4; ++kt) {
#pragma unroll
        for (int qs = 0; qs < 2; ++qs) S[qs][kt] = (f4){0.f, 0.f, 0.f, 0.f};
#pragma unroll
        for (int ks = 0; ks < DK / 32; ++ks) {
          const h8 kf = *(const h8*)(Ks + (kt * 16 + fr) * KSTR + kcol + ks * 32 + fq * 8);
#pragma unroll
          for (int qs = 0; qs < 2; ++qs) S[qs][kt] = __builtin_amdgcn_mfma_f32_16x16x32_f16(kf, qf[qs][ks], S[qs][kt], 0, 0, 0);
        }
      }
      h8 pf[2][2];
      float mxs[2];
#pragma unroll
      for (int qs = 0; qs < 2; ++qs) {
        const int qp = q0 + qs * 16 + fr;
        float mx = -3.0e38f;
        const float abase = ALIBI ? c2 * (float)(T * 64 + fq * 4 - qp) : 0.f;
        const bool need_mask = (MASK == 2) || (MASK == 1 && (T * 64 + 63 > q0));
        if (need_mask) {
#pragma unroll
          for (int kt = 0; kt < 4; ++kt)
#pragma unroll
            for (int jj = 0; jj < 4; ++jj) {
              const int kp = T * 64 + kt * 16 + fq * 4 + jj;
              float s = fmaf(S[qs][kt][jj], c1, ALIBI ? fmaf(c2, (float)(kt * 16 + jj), abase) : 0.f);
              if (MASK == 1) s = (kp <= qp) ? s : -1e30f;
              if (MASK == 2) s = (kp <= qp && qp - kp < 128) ? s : -1e30f;
              S[qs][kt][jj] = s; mx = fmaxf(mx, s);
            }
        } else {
#pragma unroll
          for (int kt = 0; kt < 4; ++kt)
#pragma unroll
            for (int jj = 0; jj < 4; ++jj) {
              const float s = fmaf(S[qs][kt][jj], c1, ALIBI ? fmaf(c2, (float)(kt * 16 + jj), abase) : 0.f);
              S[qs][kt][jj] = s; mx = fmaxf(mx, s);
            }
        }
        mx = fmaxf(mx, __shfl_xor(mx, 16)); mx = fmaxf(mx, __shfl_xor(mx, 32));
        mxs[qs] = mx;
      }
      const bool dead = __builtin_amdgcn_ballot_w64((mxs[0] - m[0] > -160.0f) || (mxs[1] - m[1] > -160.0f)) == 0;
      if (!dead) {
#pragma unroll
      for (int qs = 0; qs < 2; ++qs) {
        const float mx = fmaxf(m[qs], mxs[qs]);
        const float alpha = __builtin_amdgcn_exp2f(m[qs] - mx); m[qs] = mx;
        float ps = 0.f;
#pragma unroll
        for (int kt = 0; kt < 4; ++kt)
#pragma unroll
          for (int jj = 0; jj < 4; ++jj) { const float pv = __builtin_amdgcn_exp2f(S[qs][kt][jj] - mx); ps += pv; S[qs][kt][jj] = pv; }
        l[qs] = l[qs] * alpha + ps;
#pragma unroll
        for (int et = 0; et < DV / 16; ++et) O[qs][et] *= alpha;
#pragma unroll
        for (int pr = 0; pr < 2; ++pr)
#pragma unroll
          for (int jj = 0; jj < 4; ++jj) { pf[qs][pr][jj] = (hf)S[qs][2 * pr][jj]; pf[qs][pr][4 + jj] = (hf)S[qs][2 * pr + 1][jj]; }
      }
#pragma unroll
      for (int pr = 0; pr < 2; ++pr)
#pragma unroll
        for (int et = 0; et < DV / 16; ++et) {
          const h4 v0 = trrd(Vs + (pr * 32 + fq * 4 + (fr >> 2)) * VSTR + et * 16 + (fr & 3) * 4);
          const h4 v1 = trrd(Vs + (pr * 32 + 16 + fq * 4 + (fr >> 2)) * VSTR + et * 16 + (fr & 3) * 4);
          h8 vf; vf[0] = v0[0]; vf[1] = v0[1]; vf[2] = v0[2]; vf[3] = v0[3]; vf[4] = v1[0]; vf[5] = v1[1]; vf[6] = v1[2]; vf[7] = v1[3];
#pragma unroll
          for (int qs = 0; qs < 2; ++qs) O[qs][et] = __builtin_amdgcn_mfma_f32_16x16x32_f16(vf, pf[qs][pr], O[qs][et], 0, 0, 0);
        }
      }
    }
  }
}

__device__ __forceinline__ void swa_unit(KP p, int l, int u) {
  const int hp = u & 1, n = (u >> 1) & 15, g = (u >> 5) & 1, b = u >> 6;
  const int w = tidx() >> 6, lane = tidx() & 63, fr = lane & 15, fq = lane >> 4;
  const int hq = g * 4 + hp * 2 + (w >> 2), q0 = n * 128 + (w & 3) * 32;
  const hf* Kg = p->akv + (long)b * SEQ * 256 + g * 64; const hf* Vg = Kg + 128;
  hf* Qw = p->aq + ((long)b * SEQ + q0) * 512 + hq * 64;
  hf* Ow = p->swo + ((long)b * SEQ + q0) * 512 + hq * 64;
  const float slope = exp2f(-(float)(hq + 1));
  f4 O[2][4]; float m[2], ls[2];
  const float sink = p->in[7][l * 8 + hq] * LOG2E;
  for (int qs = 0; qs < 2; ++qs) { m[qs] = sink; ls[qs] = (fq == 0) ? 1.f : 0.f; for (int et = 0; et < 4; ++et) O[qs][et] = (f4){0.f, 0.f, 0.f, 0.f}; }
  const int T0 = (2 * n - 2) < 0 ? 0 : (2 * n - 2), T1 = 2 * n + 2;
  attn_core<64, 64, 64, true, 2>(Kg, 256, Vg, 256, T0, T1, Qw, 512, 0, q0, 0.125f * LOG2E, slope * LOG2E, O, m, ls);
  for (int qs = 0; qs < 2; ++qs) {
    float lt = ls[qs]; lt += __shfl_xor(lt, 16); lt += __shfl_xor(lt, 32);
    const float inv = 1.0f / lt;
    for (int et = 0; et < 4; ++et) *(h4*)(Ow + (long)(qs * 16 + fr) * 512 + et * 16 + fq * 4) = cvt4(O[qs][et] * inv);
  }
}

__device__ __forceinline__ void diff_unit(KP p, int l, int u) {
  const int n = 15 - (u >> 6), h = u & 3, b = (u >> 2) & 15;
  const int w = tidx() >> 6, lane = tidx() & 63, fr = lane & 15, fq = lane >> 4;
  const int comp = w & 1, q0 = n * 128 + (w >> 1) * 32;
  const hf* Kg = p->dk + (long)b * SEQ * 512 + h * 128; const hf* Vg = p->dv + (long)b * SEQ * 512 + h * 128;
  hf* Qrow = p->dq + ((long)b * SEQ + q0) * 512 + h * 128;
  hf* Orow = p->dfo + ((long)b * SEQ + q0) * 512 + h * 128;
  const float slope = exp2f(-2.0f * (float)(h + 1));
  const float lambda_init = 0.8f - 0.6f * expf(-0.3f * (float)l);
  float lam;
  { const float a = p->in[25][l * 64 + lane] * p->in[26][l * 64 + lane], c = p->in[27][l * 64 + lane] * p->in[28][l * 64 + lane];
    lam = expf(wave_sum(a)) - expf(wave_sum(c)) + lambda_init; }
  f4 O[2][8]; float m[2], ls[2];
  for (int qs = 0; qs < 2; ++qs) { m[qs] = -1e30f; ls[qs] = 0.f; for (int et = 0; et < 8; ++et) O[qs][et] = (f4){0.f, 0.f, 0.f, 0.f}; }
  attn_core<64, 128, 128, true, 1>(Kg, 512, Vg, 512, 0, 2 * n + 2, Qrow + comp * 64, 512, comp * 64, q0, 0.125f * LOG2E, slope * LOG2E, O, m, ls);
  float inv[2];
  for (int qs = 0; qs < 2; ++qs) { float lt = ls[qs]; lt += __shfl_xor(lt, 16); lt += __shfl_xor(lt, 32); inv[qs] = 1.0f / lt; }
  __syncthreads();
  float* XS = (float*)smem + (w >> 1) * 4096;
  if (comp == 1) {
    for (int qs = 0; qs < 2; ++qs) for (int et = 0; et < 8; ++et) for (int jj = 0; jj < 4; ++jj) XS[((qs * 8 + et) * 4 + jj) * 64 + lane] = O[qs][et][jj] * inv[qs];
  }
  __syncthreads();
  if (comp == 0) {
    const float* ng = p->in[29] + l * 128;
    for (int qs = 0; qs < 2; ++qs) {
      float ss = 0.f;
      for (int et = 0; et < 8; ++et) for (int jj = 0; jj < 4; ++jj) { const float v = O[qs][et][jj] * inv[qs] - lam * XS[((qs * 8 + et) * 4 + jj) * 64 + lane]; O[qs][et][jj] = v; ss += v * v; }
      ss += __shfl_xor(ss, 16); ss += __shfl_xor(ss, 32);
      const float r = rsqrtf(ss * (1.0f / 128.0f) + 1e-5f) * (1.0f - lambda_init);
      for (int et = 0; et < 8; ++et) { const f4 g4 = *(const f4*)(ng + et * 16 + fq * 4); f4 v = O[qs][et];
        for (int jj = 0; jj < 4; ++jj) v[jj] = v[jj] * r * g4[jj];
        *(h4*)(Orow + (long)(qs * 16 + fr) * 512 + et * 16 + fq * 4) = cvt4(v); }
    }
  }
}

__device__ __forceinline__ void cross_unit(KP p, int l, int u) {
  const int qb = u & 7, h = (u >> 3) & 3, b = u >> 5;
  const int w = tidx() >> 6, lane = tidx() & 63, fr = lane & 15, fq = lane >> 4;
  const int q0 = qb * 256 + w * 32;
  const hf* Kg = p->kvc + (long)l * 4096 * 1024 + (long)b * 256 * 1024 + h * 128; const hf* Vg = Kg + 512;
  const hf* Qw = p->aq + ((long)b * SEQ + q0) * 512 + h * 128;
  hf* Ow = p->dq + ((long)b * SEQ + q0) * 512 + h * 128;
  f4 O[2][8]; float m[2], ls[2];
  for (int qs = 0; qs < 2; ++qs) { m[qs] = -1e30f; ls[qs] = 0.f; for (int et = 0; et < 8; ++et) O[qs][et] = (f4){0.f, 0.f, 0.f, 0.f}; }
  attn_core<128, 128, 128, false, 0>(Kg, 1024, Vg, 1024, 0, 4, Qw, 512, 0, q0, 0.08838834764831845f * LOG2E, 0.f, O, m, ls);
  for (int qs = 0; qs < 2; ++qs) {
    float lt = ls[qs]; lt += __shfl_xor(lt, 16); lt += __shfl_xor(lt, 32);
    const float inv = 1.0f / lt;
    for (int et = 0; et < 8; ++et) *(h4*)(Ow + (long)(qs * 16 + fr) * 512 + et * 16 + fq * 4) = cvt4(O[qs][et] * inv);
  }
}

__device__ __forceinline__ void s5_unit(KP p, int l, int u) {
  const int b = u >> 2, w = tidx() >> 6, g = (u & 3) * 8 + w, lane = tidx() & 63, fr = lane & 15, fq = lane >> 4;
  float* BuS = (float*)(smem + w * 12800);
  float* Yt = BuS + 16 * 132;
  const int lg = l * 32 + g;
  const float step = expf(p->in[11][lg]);
  float abr, abi;
  { const float ar = p->in[9][lg * 64 + lane], ai = p->in[10][lg * 64 + lane]; const float mag = expf(ar * step); abr = mag * cosf(ai * step); abi = mag * sinf(ai * step); }
  h8 bfr[8];
#pragma unroll
  for (int nt = 0; nt < 8; ++nt) {
    const int pp = (nt & 3) * 16 + fr;
    const float ar = p->in[9][lg * 64 + pp], ai = p->in[10][lg * 64 + pp]; const float mag = expf(ar * step);
    const float nr = mag * cosf(ai * step) - 1.0f, ni = mag * sinf(ai * step), den = ar * ar + ai * ai;
    const float cr = (nr * ar + ni * ai) / den, ci = (ni * ar - nr * ai) / den;
    const float* brp = p->in[12] + ((long)lg * 64 + pp) * 16 + (fq & 1) * 8; const float* bip = p->in[13] + ((long)lg * 64 + pp) * 16 + (fq & 1) * 8;
#pragma unroll
    for (int s = 0; s < 8; ++s) { const float v = (nt < 4) ? (cr * brp[s] - ci * bip[s]) : (cr * bip[s] + ci * brp[s]); bfr[nt][s] = (fq < 2) ? (hf)v : (hf)0.0f; }
  }
  h8 cfr[4];
#pragma unroll
  for (int ks = 0; ks < 4; ++ks) {
    const float* src = (ks < 2 ? p->in[14] : p->in[15]) + ((long)lg * 16 + fr) * 64 + (ks & 1) * 32 + fq * 8;
    const float sg = ks < 2 ? 1.0f : -1.0f;
#pragma unroll
    for (int j = 0; j < 8; ++j) cfr[ks][j] = (hf)(sg * src[j]);
  }
  h8 dfr;
  { const float dd = p->in[16][l * 512 + g * 16 + fr];
#pragma unroll
    for (int s = 0; s < 8; ++s) dfr[s] = (fq < 2 && (fq & 1) * 8 + s == fr) ? (hf)dd : (hf)0.0f; }
  float xr = 0.f, xi = 0.f;
  const hf* up = p->su + (long)b * SEQ * 512 + g * 16 + (fq & 1) * 8;
  hf* yp = p->s5tmp + (long)b * SEQ * 512 + g * 16;
  h8 un = *(const h8*)(up + (long)fr * 512);
#pragma unroll 1
  for (int ch = 0; ch < 128; ++ch) {
    h8 uf = un;
    if (fq >= 2) { for (int s = 0; s < 8; ++s) uf[s] = (hf)0.0f; }
    if (ch < 127) un = *(const h8*)(up + (long)((ch + 1) * 16 + fr) * 512);
#pragma unroll
    for (int nt = 0; nt < 8; ++nt) {
      const f4 d = __builtin_amdgcn_mfma_f32_16x16x32_f16(uf, bfr[nt], (f4){0.f, 0.f, 0.f, 0.f}, 0, 0, 0);
#pragma unroll
      for (int jj = 0; jj < 4; ++jj) BuS[(fq * 4 + jj) * 132 + nt * 16 + fr] = d[jj];
    }
    __syncthreads();
    float br_[16], bi_[16];
#pragma unroll
    for (int t = 0; t < 16; ++t) { br_[t] = BuS[t * 132 + lane]; bi_[t] = BuS[t * 132 + 64 + lane]; }
#pragma unroll
    for (int t = 0; t < 16; ++t) {
      const float nxr = abr * xr - abi * xi + br_[t], nxi = abr * xi + abi * xr + bi_[t]; xr = nxr; xi = nxi;
      BuS[t * 132 + lane] = xr; BuS[t * 132 + 64 + lane] = xi;
    }
    __syncthreads();
    f4 y = (f4){0.f, 0.f, 0.f, 0.f};
#pragma unroll
    for (int ks = 0; ks < 4; ++ks) {
      const f4 xa = *(const f4*)(BuS + fr * 132 + ks * 32 + fq * 8), xb = *(const f4*)(BuS + fr * 132 + ks * 32 + fq * 8 + 4);
      h8 xf; xf[0] = (hf)xa[0]; xf[1] = (hf)xa[1]; xf[2] = (hf)xa[2]; xf[3] = (hf)xa[3]; xf[4] = (hf)xb[0]; xf[5] = (hf)xb[1]; xf[6] = (hf)xb[2]; xf[7] = (hf)xb[3];
      y = __builtin_amdgcn_mfma_f32_16x16x32_f16(xf, cfr[ks], y, 0, 0, 0);
    }
    y = __builtin_amdgcn_mfma_f32_16x16x32_f16(uf, dfr, y, 0, 0, 0);
#pragma unroll
    for (int jj = 0; jj < 4; ++jj) {
      const float v = y[jj], z = 0.7978845608028654f * (v + 0.044715f * v * v * v);
      const float th = 1.0f - 2.0f * __builtin_amdgcn_rcpf(__builtin_amdgcn_exp2f(2.8853900817779268f * z) + 1.0f);
      Yt[(fq * 4 + jj) * 20 + fr] = 0.5f * v * (1.0f + th);
    }
    __syncthreads();
    { const int t = lane >> 2, c4 = (lane & 3) * 4; const f4 v = *(const f4*)(Yt + t * 20 + c4);
      *(h4*)(yp + (long)(ch * 16 + t) * 512 + c4) = cvt4(v); }
  }
}

__device__ __forceinline__ void conv_unit(KP p, int l, int u) {
  const int b = u >> 5, t0 = (u & 31) * 64, tid = tidx(), w = tid >> 6, lane = tid & 63;
  hf* G = (hf*)smem;
  hf* Wc = (hf*)(smem + 96256);
  for (int idx = tid; idx < 94 * 64; idx += 512) {
    const int r = idx >> 6, c8 = idx & 63, t = t0 - 30 + r; h8 o;
    if (t >= 0) { const hf* src = p->cu + ((long)b * SEQ + t) * 1024 + c8 * 8; const h8 v = *(const h8*)src, gt = *(const h8*)(src + 512);
      for (int j = 0; j < 8; ++j) o[j] = (hf)((float)v[j] * sigmoidf_((float)gt[j])); }
    else { for (int j = 0; j < 8; ++j) o[j] = (hf)0.0f; }
    *(h8*)(G + r * 512 + c8 * 8) = o;
  }
  { const float* cw = p->in[20] + (long)l * 31 * 512; for (int idx = tid; idx < 31 * 512; idx += 512) Wc[idx] = (hf)cw[idx]; }
  __syncthreads();
  const float* cb = p->in[21] + l * 512 + lane * 8; const f4 b0 = *(const f4*)cb, b1 = *(const f4*)(cb + 4);
  const float* lg = p->in[22] + l * 512 + lane * 8; const float* lb = p->in[23] + l * 512 + lane * 8;
  const f4 g0 = *(const f4*)lg, g1 = *(const f4*)(lg + 4), c0 = *(const f4*)lb, c1 = *(const f4*)(lb + 4);
#pragma unroll 1
  for (int jp = 0; jp < 4; ++jp) {
    float a0[8], a1[8];
#pragma unroll
    for (int c = 0; c < 8; ++c) { a0[c] = c < 4 ? b0[c & 3] : b1[c & 3]; a1[c] = a0[c]; }
    const hf* gp = G + (w * 8 + jp * 2) * 512 + lane * 8;
    h8 wprev;
#pragma unroll
    for (int c = 0; c < 8; ++c) wprev[c] = (hf)0.0f;
#pragma unroll 8
    for (int k = 0; k < 32; ++k) {
      const h8 gv = *(const h8*)(gp + k * 512);
      h8 wv;
      if (k < 31) wv = *(const h8*)(Wc + k * 512 + lane * 8); else { for (int c = 0; c < 8; ++c) wv[c] = (hf)0.0f; }
#pragma unroll
      for (int c = 0; c < 8; ++c) { a0[c] += (float)gv[c] * (float)wv[c]; a1[c] += (float)gv[c] * (float)wprev[c]; }
      wprev = wv;
    }
#pragma unroll
    for (int jj = 0; jj < 2; ++jj) {
      float s = 0.f;
#pragma unroll
      for (int c = 0; c < 8; ++c) s += jj ? a1[c] : a0[c];
      const float mu = wave_sum(s) * (1.0f / 512.0f);
      float q = 0.f;
#pragma unroll
      for (int c = 0; c < 8; ++c) { const float d = (jj ? a1[c] : a0[c]) - mu; q += d * d; }
      const float rs = rsqrtf(wave_sum(q) * (1.0f / 512.0f) + 1e-5f);
      h8 o;
#pragma unroll
      for (int c = 0; c < 8; ++c) { const float gg = c < 4 ? g0[c & 3] : g1[c & 3], bb = c < 4 ? c0[c & 3] : c1[c & 3];
        const float v = ((jj ? a1[c] : a0[c]) - mu) * rs * gg + bb; o[c] = (hf)(v * sigmoidf_(v)); }
      *(h8*)(p->convout + ((long)b * SEQ + t0 + w * 8 + jp * 2 + jj) * 512 + lane * 8) = o;
    }
  }
}

__device__ __forceinline__ void phase_mixers(KP p, int l, int cidx) {
  volatile int* ctl = (volatile int*)(smem + CTL_OFF);
  const int NS5 = 64, NDIFF = 1024, NSWA = 1024, NCONV = 512, TOTAL = NS5 + NDIFF + NSWA + NCONV;
  for (;;) {
    __syncthreads();
    if (tidx() == 0) *ctl = (int)atomicAdd(p->counters + cidx, 1u);
    __syncthreads();
    const int it = *ctl;
    if (it >= TOTAL) break;
    if (it < NS5) s5_unit(p, l, it);
    else if (it < NS5 + NDIFF) diff_unit(p, l, it - NS5);
    else if (it < NS5 + NDIFF + NCONV) conv_unit(p, l, it - NS5 - NDIFF);
    else swa_unit(p, l, it - NS5 - NDIFF - NCONV);
  }
}
__device__ __forceinline__ void phase_cross_attn(KP p, int l) {
  for (int u = blockIdx.x; u < 512; u += gridDim.x) { __syncthreads(); cross_unit(p, l, u); }
}

__global__ void __launch_bounds__(512) fwd_megakernel(Params pv) {
  cg::grid_group grid = cg::this_grid();
  if (tidx() == 0) { const unsigned long long kp = (unsigned long long)__builtin_amdgcn_kernarg_segment_ptr();
    volatile __attribute__((address_space(3))) unsigned* s = (volatile __attribute__((address_space(3))) unsigned*)(smem + 136 * 1024 + 16);
    s[0] = (unsigned)kp; s[1] = (unsigned)(kp >> 32); s[4] = 0u; s[5] = 0u; }
  __syncthreads();
  if (tidx() == 0) (void)xb_add(&getp()->counters[XB_XCNT(xb_xcc_id())], 1u);
  phase_init(getp());
  grid.sync();
#pragma unroll 1
  for (int j = 0; j < 8; ++j) {
    const int l = j >> 1, second = j & 1;
    phase_ffn_a(getp(), second ? getp()->w1in : getp()->wbin, j == 0);
    gbar();
    phase_resid_ln(getp(), getp()->aq, FFN, second ? getp()->w1out : getp()->wbout, FFN, 0.5f, getp()->in[second ? 43 : 4] + l * 1024, getp()->in[second ? 44 : 5] + l * 1024, j == 7 ? getp()->out : (float*)nullptr, l * 4 + (second ? 3 : 0));
    if (!second) convert_mix(getp(), l);
    else if (l < 3) convert_ffn(getp(), getp()->in[2] + (long)(l + 1) * 1024 * 2 * FFN, getp()->in[3] + (long)(l + 1) * FFN * 1024, getp()->wbin, getp()->wbout);
    gbar();
    if (!second) {
      phase_mix_a(getp());
      gbar();
      phase_mixers(getp(), l, l);
      gbar();
      phase_s5_glu(getp(), l);
      gbar();
      phase_merge(getp());
      gbar();
      phase_resid_ln(getp(), getp()->cu, 1024, getp()->wout, 1024, 1.0f, getp()->in[32] + l * 1024, getp()->in[33] + l * 1024, (float*)nullptr, l * 4 + 1);
      convert_cross(getp(), l);
      gbar();
      phase_plain(getp()->x16, 1024, getp()->wq, 1024, getp()->aq, 512, 128, 2);
      gbar();
      phase_cross_attn(getp(), l);
      gbar();
      phase_resid_ln(getp(), getp()->dq, 512, getp()->wo, 512, 1.0f, getp()->in[39] + l * 1024, getp()->in[40] + l * 1024, (float*)nullptr, l * 4 + 2);
      convert_ffn(getp(), getp()->in[41] + (long)l * 1024 * 2 * FFN, getp()->in[42] + (long)l * FFN * 1024, getp()->w1in, getp()->w1out);
      gbar();
    }
  }
}

extern "C" void kernel_launch(void* const* d_in, const int* in_sizes, int n_in, void* d_out, int out_size, void* d_ws, size_t ws_size, hipStream_t stream) {
  Params p; memset(&p, 0, sizeof(p));
  for (int i = 0; i < 45; ++i) p.in[i] = (const float*)d_in[i];
  p.out = (float*)d_out;
  char* base = (char*)d_ws; size_t off = 0;
  auto carve = [&](size_t halves) { hf* r = (hf*)(base + off); off += (halves * 2 + 255) & ~(size_t)255; return r; };
  p.counters = (unsigned*)base; off = 32768;
  p.x16 = carve((size_t)NTOK * 1024);
  p.w1in = carve((size_t)5632 * 1024); p.w1out = carve((size_t)1024 * FFN);
  p.wbin = carve((size_t)5632 * 1024); p.wbout = carve((size_t)1024 * FFN);
  p.wmix = carve((size_t)7936 * 1024);
  p.pswa = carve(1024 * 512); p.ps5 = carve(1024 * 512); p.pconv = carve(1024 * 512); p.pdiff = carve(1024 * 512);
  p.glu = carve(512 * 512); p.wout = carve(1024 * 1024); p.wq = carve(512 * 1024); p.wo = carve(1024 * 512);
  p.wkv = carve((size_t)4 * 1024 * 1024); p.kvc = carve((size_t)4 * 4096 * 1024); p.memn = carve((size_t)4096 * 1024);
  p.aq = carve((size_t)NTOK * 512); p.akv = carve((size_t)NTOK * 256); p.dq = carve((size_t)NTOK * 512);
  p.dk = carve((size_t)NTOK * 512); p.dv = carve((size_t)NTOK * 512); p.su = carve((size_t)NTOK * 512); p.cu = carve((size_t)NTOK * 1024);
  p.s5tmp = carve((size_t)NTOK * 512); p.convout = carve((size_t)NTOK * 512);
  p.swo = carve((size_t)NTOK * 512); p.dfo = carve((size_t)NTOK * 512);
  p.xstat = (unsigned long long*)carve((size_t)NTOK * 4 * 4);
  static int grid_blocks = 0;
  if (!grid_blocks) {
    hipFuncSetAttribute((const void*)fwd_megakernel, hipFuncAttributeMaxDynamicSharedMemorySize, LDS_BYTES);
    int dev = 0, cus = 0, per_cu = 0;
    hipGetDevice(&dev);
    hipDeviceGetAttribute(&cus, hipDeviceAttributeMultiprocessorCount, dev);
    hipOccupancyMaxActiveBlocksPerMultiprocessor(&per_cu, fwd_megakernel, 512, LDS_BYTES);
    if (per_cu > 1) per_cu = 1;
    grid_blocks = cus * per_cu;
    if (grid_blocks <= 0) grid_blocks = 256;
  }
  (void)hipMemsetAsync(d_ws, 0, 32768, stream);
  void* args[] = {&p};
  hipError_t e = hipLaunchCooperativeKernel((const void*)fwd_megakernel, dim3(grid_blocks), dim3(512), args, LDS_BYTES, stream);
  if (e != hipSuccess) fprintf(stderr, "cooperative launch failed: %s (grid %d)\n", hipGetErrorString(e), grid_blocks);
}
```

```cpp
#include <hip/hip_runtime.h>
#include <hip/hip_cooperative_groups.h>
#include <cstdio>
#include <cstring>
namespace cg = cooperative_groups;

typedef _Float16 hf;
typedef _Float16 h8 __attribute__((ext_vector_type(8)));
typedef _Float16 h4 __attribute__((ext_vector_type(4)));
typedef short s4v __attribute__((ext_vector_type(4)));
typedef float f4 __attribute__((ext_vector_type(4)));

constexpr int NTOK = 32768, SEQ = 2048, FFN = 2816;
constexpr int LDS_BYTES = 140 * 1024;
constexpr int CTL_OFF = 136 * 1024;
constexpr float LOG2E = 1.4426950408889634f;
constexpr float DN_ALPHA = 1.681792830507429f;

struct Params {
  const float* in[45];
  float* out;
  hf *x16, *w1in, *w1out, *wbin, *wbout, *wmix, *pswa, *ps5, *pconv, *pdiff, *glu, *wout, *wq, *wo, *wkv, *kvc, *memn;
  hf *aq, *akv, *dq, *dk, *dv, *su, *cu, *s5tmp, *convout, *swo, *dfo;
  unsigned long long* xstat;
  unsigned* counters;
  unsigned pad_;
  unsigned pad2_;
};

extern __shared__ __attribute__((aligned(16))) unsigned char smem[];
__device__ __forceinline__ int tidx() { int t = __builtin_amdgcn_workitem_id_x(); asm volatile("" : "+v"(t)); return t; }
typedef const __attribute__((address_space(4))) Params* KP;
__device__ __forceinline__ KP getp() {
  volatile __attribute__((address_space(3))) unsigned* s = (volatile __attribute__((address_space(3))) unsigned*)(smem + 136 * 1024 + 16);
  const unsigned lo = __builtin_amdgcn_readfirstlane(s[0]), hi = __builtin_amdgcn_readfirstlane(s[1]);
  unsigned long long v = ((unsigned long long)hi << 32) | lo;
  asm volatile("" : "+s"(v));
  return (KP)v;
}

#define XB_TMO      128
#define XB_XCNT(j)  (256  + 64 * (j))
#define XB_XSUB(j)  (1280 + 64 * (j))
#define XB_XGEN(j)  (2304 + 64 * (j))
#define XB_TOP      3328
#define XB_TOPGEN   3392
#define XB_SPIN_CAP (1u << 20)
__device__ __forceinline__ unsigned xb_ld(unsigned* p)              { return __hip_atomic_load(p, __ATOMIC_RELAXED, __HIP_MEMORY_SCOPE_AGENT); }
__device__ __forceinline__ unsigned xb_add(unsigned* p, unsigned v) { return __hip_atomic_fetch_add(p, v, __ATOMIC_RELAXED, __HIP_MEMORY_SCOPE_AGENT); }
__device__ __forceinline__ unsigned xb_xcc_id() { return (unsigned)__builtin_amdgcn_s_getreg((3 << 11) | 20) & 0xFu; }
#define XB_SPIN(cond, bar) do { unsigned _sp = 0; while (cond) { __builtin_amdgcn_s_sleep(1); \
    if ((++_sp & 255u) == 0u) { if (xb_ld(&(bar)[XB_TMO])) break; if (_sp > XB_SPIN_CAP) { atomicAdd(&(bar)[XB_TMO], 1u); break; } } } } while (0)
__device__ __forceinline__ void xcd_barrier_complete(unsigned* bar, unsigned x, unsigned& nloc, unsigned& nx) {
  const unsigned G = gridDim.x;
  unsigned sum, cnt, mine, sp = 0u;
  for (;;) {
    sum = 0u; cnt = 0u; mine = 0u;
#pragma unroll
    for (unsigned j = 0; j < 16; ++j) { const unsigned c = xb_ld(&bar[XB_XCNT(j)]); sum += c; cnt += (c > 0u) ? 1u : 0u; mine = (j == x) ? c : mine; }
    if (sum == G) break;
    __builtin_amdgcn_s_sleep(1);
    if ((++sp & 255u) == 0u) { if (xb_ld(&bar[XB_TMO])) break; if (sp > XB_SPIN_CAP) { atomicAdd(&bar[XB_TMO], 1u); break; } }
  }
  nloc = mine > 0u ? mine : 1u; nx = cnt > 0u ? cnt : 1u;
}
__device__ __forceinline__ void gbar() {
  asm volatile("s_waitcnt vmcnt(0)" ::: "memory");
  __syncthreads();
  if (tidx() == 0) {
    unsigned* bar = getp()->counters;
    volatile __attribute__((address_space(3))) unsigned* st = (volatile __attribute__((address_space(3))) unsigned*)(smem + 136 * 1024 + 32);
    const unsigned x = xb_xcc_id();
    __builtin_amdgcn_s_waitcnt(0);
    unsigned nloc = st[0], nx = st[1];
    if (nloc == 0u) { xcd_barrier_complete(bar, x, nloc, nx); st[0] = nloc; st[1] = nx; }
    const unsigned old = xb_add(&bar[XB_XSUB(x)], 1u);
    const unsigned gen = old / nloc;
    if (old + 1u == (gen + 1u) * nloc) {
      __builtin_amdgcn_fence(__ATOMIC_RELEASE, "agent");
      asm volatile("s_waitcnt vmcnt(0)" ::: "memory");
      const unsigned og = xb_add(&bar[XB_TOP], 1u);
      const unsigned tg = og / nx;
      if (og + 1u == (tg + 1u) * nx) xb_add(&bar[XB_TOPGEN], 1u);
      else XB_SPIN(xb_ld(&bar[XB_TOPGEN]) == tg, bar);
      __builtin_amdgcn_fence(__ATOMIC_ACQUIRE, "agent");
      xb_add(&bar[XB_XGEN(x)], 1u);
      asm volatile("s_waitcnt vmcnt(0)" ::: "memory");
    } else {
      XB_SPIN(xb_ld(&bar[XB_XGEN(x)]) == gen, bar);
      __builtin_amdgcn_fence(__ATOMIC_ACQUIRE, "agent");
      asm volatile("s_waitcnt vmcnt(0)" ::: "memory");
    }
  }
  __syncthreads();
}

constexpr int BM = 256, BK = 64, HALFT = 128, HT = HALFT * BK;
__device__ __forceinline__ int lds_byte(int r, int c) {
  int st = (r >> 4) * 2 + (c >> 5), rr = r & 15, cc = c & 31, ob = rr * 64 + cc * 2;
  return st * 1024 + (ob ^ (((ob >> 9) & 1) << 5));
}
__device__ __forceinline__ void stage_rc(int b, int& R, int& C) {
  int st = b / 1024, sb = b % 1024, swz = sb ^ (((sb >> 9) & 1) << 5);
  R = (st >> 1) * 16 + swz / 64; C = (st & 1) * 32 + (swz % 64) / 2;
}
__device__ __forceinline__ bool tile_order(int i, int nM, int nN, int& pm, int& pn) {
  const int nwg = nM * nN; const int L = i * (int)gridDim.x + (int)blockIdx.x; if (L >= nwg) return false;
  int wgid = (int)L; { const int q = nwg / 8, r = nwg % 8, xcd = wgid % 8, off = wgid / 8; wgid = (xcd < r ? xcd * (q + 1) : r * (q + 1) + (xcd - r) * q) + off; }
  const int nig = 8 * nN, gid = wgid / nig, fm = gid * 8, gsz = (nM - fm) < 8 ? (nM - fm) : 8;
  pm = fm + ((wgid % nig) % gsz); pn = (wgid % nig) / gsz; return true;
}

#define LAS __attribute__((address_space(3)))
constexpr int HTB = HALFT * BK * 2;
struct GU { const char* A; const char* B; int lda, ldb, nt, brow, bcol, aux; };

template <class Prov, class Epi>
__device__ __forceinline__ void gemm_stream(Prov prov, Epi epi) {
  LAS unsigned char* lds = (LAS unsigned char*)smem;
  const int tid = tidx();
  const int wid = __builtin_amdgcn_readfirstlane(tid >> 6), lane = tid & 63, wr = wid >> 2, wc = wid & 3, fr = lane & 15, fq = lane >> 4;
  int sR[2], sC[2];
#pragma unroll
  for (int i = 0; i < 2; ++i) stage_rc(tid * 16 + i * 8192, sR[i], sC[i]);
  const size_t kstep = (size_t)(BK * 2);
  const unsigned ldsw = (unsigned)wid * 1024u;
  const int aoff = lds_byte(wr * 64 + fr, fq * 8), boff = lds_byte(wc * 32 + fr, fq * 8);
  GU cur, nxt;
  if (!prov(0, cur)) return;
  int ui = 0;
#define GSA(b, h) (((b)*2 + (h)) * HTB)
#define GSB(b, h) ((4 + (b)*2 + (h)) * HTB)
#define STAGE(bufoff, gbase, ld) do { _Pragma("unroll") for (int _i = 0; _i < 2; ++_i) \
    __builtin_amdgcn_global_load_lds((const unsigned*)((const char*)(gbase) + (unsigned)((sR[_i] * (ld) + sC[_i]) * 2)), (LAS unsigned*)(lds + (bufoff) + ldsw + _i * 8192), 16, 0, 0); } while (0)
#define LDA(dst, b, h) do { _Pragma("unroll") for (int m = 0; m < 4; ++m) _Pragma("unroll") for (int k = 0; k < 2; ++k) dst[m][k] = *(const LAS h8*)(lds + GSA(b, h) + aoff + m * 2048 + k * 1024); } while (0)
#define LDB(dst, b, h) do { _Pragma("unroll") for (int n = 0; n < 2; ++n) _Pragma("unroll") for (int k = 0; k < 2; ++k) dst[n][k] = *(const LAS h8*)(lds + GSB(b, h) + boff + n * 2048 + k * 1024); } while (0)
#define MMA(ai, bj, At_, Bt_) do { __builtin_amdgcn_s_setprio(1); _Pragma("unroll") for (int m = 0; m < 4; ++m) _Pragma("unroll") for (int n = 0; n < 2; ++n) _Pragma("unroll") for (int k = 0; k < 2; ++k) \
      acc[ai][bj][m][n] = __builtin_amdgcn_mfma_f32_16x16x32_f16(Bt_[n][k], At_[m][k], acc[ai][bj][m][n], 0, 0, 0); \
    __builtin_amdgcn_s_setprio(0); } while (0)
#define WAIT_V(n) asm volatile("s_waitcnt vmcnt(" #n ")" ::: "memory")
#define WAIT_L(n) asm volatile("s_waitcnt lgkmcnt(" #n ")" ::: "memory")
#define BAR __builtin_amdgcn_s_barrier()
#define SCHED __builtin_amdgcn_sched_barrier(0)
#define ZERO_ACC _Pragma("unroll") for (int a = 0; a < 2; ++a) _Pragma("unroll") for (int b = 0; b < 2; ++b) _Pragma("unroll") for (int m = 0; m < 4; ++m) _Pragma("unroll") for (int n = 0; n < 2; ++n) acc[a][b][m][n] = (f4){0.f, 0.f, 0.f, 0.f}
  f4 acc[2][2][4][2];
  ZERO_ACC;
  h8 At[4][2], B0[2][2], B1[2][2];
  { const size_t hA = (size_t)HALFT * cur.lda * 2, hB = (size_t)HALFT * cur.ldb * 2;
    STAGE(GSB(0, 0), cur.B, cur.ldb); STAGE(GSB(0, 1), cur.B + hB, cur.ldb); STAGE(GSA(0, 0), cur.A, cur.lda); STAGE(GSA(0, 1), cur.A + hA, cur.lda);
    if (wr == 1) BAR;
    WAIT_V(2); BAR;
    STAGE(GSB(1, 0), cur.B + kstep, cur.ldb); STAGE(GSA(1, 0), cur.A + kstep, cur.lda); STAGE(GSB(1, 1), cur.B + hB + kstep, cur.ldb);
    WAIT_V(6); BAR; }
#pragma unroll 1
  for (;;) {
    const bool has_next = prov(ui + 1, nxt);
    if (!has_next) nxt = cur;
    const int nt = cur.nt;
    const size_t hA = (size_t)HALFT * cur.lda * 2;
#pragma unroll 1
    for (int t = 0; t < nt; t += 2) {
      const bool last = (t + 2 >= nt);
      const char* a1 = cur.A + (size_t)(t + 1) * kstep + hA;
      const char* a2 = last ? nxt.A : cur.A + (size_t)(t + 2) * kstep;
      const char* b2 = last ? nxt.B : cur.B + (size_t)(t + 2) * kstep;
      const int lda2 = last ? nxt.lda : cur.lda, ldb2 = last ? nxt.ldb : cur.ldb;
      const size_t hA2 = (size_t)HALFT * lda2 * 2, hB2 = (size_t)HALFT * ldb2 * 2;
      LDB(B0, 0, 0); LDB(B1, 0, 1); SCHED; LDA(At, 0, 0); STAGE(GSA(1, 1), a1, cur.lda);
      WAIT_V(8); WAIT_L(0); BAR; MMA(0, 0, At, B0); MMA(0, 1, At, B1); BAR; SCHED;
      LDA(At, 0, 1); STAGE(GSB(0, 0), b2, ldb2); STAGE(GSB(0, 1), b2 + hB2, ldb2); STAGE(GSA(0, 0), a2, lda2);
      WAIT_V(8); WAIT_L(0); BAR; MMA(1, 0, At, B0); MMA(1, 1, At, B1); BAR; SCHED;
      LDB(B0, 1, 0); LDB(B1, 1, 1); SCHED; LDA(At, 1, 0); STAGE(GSA(0, 1), a2 + hA2, lda2);
      WAIT_V(8); WAIT_L(0); BAR; MMA(0, 0, At, B0); MMA(0, 1, At, B1); BAR; SCHED;
      LDA(At, 1, 1); STAGE(GSB(1, 0), b2 + kstep, ldb2); STAGE(GSB(1, 1), b2 + hB2 + kstep, ldb2); STAGE(GSA(1, 0), a2 + kstep, lda2);
      WAIT_V(8); WAIT_L(0); BAR; MMA(1, 0, At, B0); MMA(1, 1, At, B1); BAR; SCHED;
    }
    if (wr == 0) BAR;
    epi(acc, cur, wr, wc, fr, fq);
    ZERO_ACC;
    if (!has_next) break;
    cur = nxt; ++ui;
    if (wr == 1) BAR;
  }
  asm volatile("s_waitcnt vmcnt(0)" ::: "memory");
  __syncthreads();
#undef GSA
#undef GSB
#undef STAGE
#undef LDA
#undef LDB
#undef MMA
#undef ZERO_ACC
}

#define EPI_ARGS f4 (&acc)[2][2][4][2], const GU& d, int wr, int wc, int fr, int fq
#define EPI_ROWS _Pragma("unroll") for (int ai = 0; ai < 2; ++ai) _Pragma("unroll") for (int m = 0; m < 4; ++m)
#define EPI_COLS _Pragma("unroll") for (int bj = 0; bj < 2; ++bj) _Pragma("unroll") for (int n = 0; n < 2; ++n)
#define AINL __attribute__((always_inline))

__device__ __forceinline__ float sigmoidf_(float x) { return __builtin_amdgcn_rcpf(1.0f + __builtin_amdgcn_exp2f(-1.4426950408889634f * x)); }
__device__ __forceinline__ h4 cvt4(f4 v) { h4 r; r[0] = (hf)v[0]; r[1] = (hf)v[1]; r[2] = (hf)v[2]; r[3] = (hf)v[3]; return r; }
__device__ __forceinline__ h8 cvt8(f4 a, f4 b) { h8 r; r[0] = (hf)a[0]; r[1] = (hf)a[1]; r[2] = (hf)a[2]; r[3] = (hf)a[3]; r[4] = (hf)b[0]; r[5] = (hf)b[1]; r[6] = (hf)b[2]; r[7] = (hf)b[3]; return r; }
#define EPI_BJ _Pragma("unroll") for (int bj = 0; bj < 2; ++bj)
__device__ __forceinline__ void set_gu(GU& d, const hf* A, int lda, const hf* B, int ldb, int K, int brow, int bcol, int aux) {
  d.A = (const char*)(A + (size_t)brow * lda); d.B = (const char*)(B + (size_t)bcol * ldb); d.lda = lda; d.ldb = ldb; d.nt = K / BK; d.brow = brow; d.bcol = bcol; d.aux = aux;
}

__device__ __forceinline__ void phase_ffn_a(KP p, const hf* w_in, bool with_kv) {
  hf* hidden = p->aq; hf* kvc = p->kvc;
  const hf* x16 = p->x16; const hf* memn = p->memn; const hf* wkv = p->wkv;
  const int nA = 128 * 22, total = nA + (with_kv ? 256 : 0);
  gemm_stream([&](int i, GU& d) AINL -> bool {
      const int L = i * (int)gridDim.x + (int)blockIdx.x; if (L >= total) return false;
      if (L < nA) {
        int wgid = (int)L; const int q = nA / 8, off = wgid / 8, xcd = wgid % 8; wgid = xcd * q + off;
        const int nig = 8 * 22, gid = wgid / nig, fm = gid * 8, pm = fm + ((wgid % nig) % 8), pn = (wgid % nig) / 8;
        set_gu(d, x16, 1024, w_in, 1024, 1024, pm * 256, pn * 256, 0);
      } else {
        const int t = (int)L - nA, l = t >> 6, pm = (t & 63) >> 2, pn = t & 3;
        set_gu(d, memn, 1024, wkv + (size_t)l * 1024 * 1024, 1024, 1024, pm * 256, pn * 256, 1 + l);
      }
      return true; },
    [&](EPI_ARGS) AINL {
      if (d.aux == 0) {
        EPI_ROWS { const long row = d.brow + ai * 128 + wr * 64 + m * 16 + fr;
          f4 v[2];
          _Pragma("unroll") for (int n = 0; n < 2; ++n) { const f4 g = acc[ai][0][m][n], u = acc[ai][1][m][n];
            _Pragma("unroll") for (int j = 0; j < 4; ++j) v[n][j] = g[j] * sigmoidf_(g[j]) * u[j]; }
          *(h8*)(hidden + row * FFN + (d.bcol >> 1) + wc * 32 + fq * 8) = cvt8(v[0], v[1]); }
      } else {
        hf* dst = kvc + (size_t)(d.aux - 1) * 4096 * 1024;
        EPI_ROWS { const long row = d.brow + ai * 128 + wr * 64 + m * 16 + fr;
          EPI_BJ { *(h8*)(dst + row * 1024 + d.bcol + bj * 128 + wc * 32 + fq * 8) = cvt8(acc[ai][bj][m][0], acc[ai][bj][m][1]); } }
      } });
}

__device__ __forceinline__ void phase_resid(KP p, const hf* A, int lda, const hf* Wt, int K, float scale) {
  hf* y16 = p->s5tmp; const hf* res = p->x16;
  gemm_stream([&](int i, GU& d) AINL -> bool { int pm, pn; if (!tile_order(i, 128, 4, pm, pn)) return false; set_gu(d, A, lda, Wt, K, K, pm * 256, pn * 256, 0); return true; },
    [&](EPI_ARGS) AINL {
      EPI_ROWS { const long row = d.brow + ai * 128 + wr * 64 + m * 16 + fr;
        EPI_BJ { const long o = row * 1024 + d.bcol + bj * 128 + wc * 32 + fq * 8;
          const h8 r = *(const h8*)(res + o); f4 v0 = acc[ai][bj][m][0], v1 = acc[ai][bj][m][1];
          _Pragma("unroll") for (int j = 0; j < 4; ++j) { v0[j] = DN_ALPHA * (float)r[j] + scale * v0[j]; v1[j] = DN_ALPHA * (float)r[4 + j] + scale * v1[j]; }
          *(h8*)(y16 + o) = cvt8(v0, v1); } } });
}

__device__ __forceinline__ void phase_resid_ln(KP p, const hf* A, int lda, const hf* Wt, int K, float scale, const float* lng, const float* lnb, float* out32, int seq) {
  hf* x16 = p->x16; unsigned long long* xs = p->xstat; unsigned* pcnt = p->counters + 4096;
  gemm_stream([&](int i, GU& d) AINL -> bool { int pm, pn; if (!tile_order(i, 128, 4, pm, pn)) return false; set_gu(d, A, lda, Wt, K, K, pm * 256, pn * 256, pn); return true; },
    [&](EPI_ARGS) AINL {
      LAS float* P = (LAS float*)((LAS unsigned char*)smem + 131072);
      const int tid = tidx();
      EPI_ROWS { const int rl = ai * 128 + wr * 64 + m * 16 + fr; const long row = d.brow + rl; float s = 0.f, q = 0.f;
        EPI_BJ { const long o = row * 1024 + d.bcol + bj * 128 + wc * 32 + fq * 8; const h8 r = *(const h8*)(x16 + o);
          _Pragma("unroll") for (int j = 0; j < 4; ++j) { const float a0 = DN_ALPHA * (float)r[j] + scale * acc[ai][bj][m][0][j], a1 = DN_ALPHA * (float)r[4 + j] + scale * acc[ai][bj][m][1][j];
            acc[ai][bj][m][0][j] = a0; acc[ai][bj][m][1][j] = a1; s += a0 + a1; q += a0 * a0 + a1 * a1; } }
        s += __shfl_xor(s, 16); s += __shfl_xor(s, 32); q += __shfl_xor(q, 16); q += __shfl_xor(q, 32);
        if (fq == 0) { P[(rl * 4 + wc) * 2] = s; P[(rl * 4 + wc) * 2 + 1] = q; } }
      __syncthreads();
      if (tid < 256) { float s = 0.f, q = 0.f; _Pragma("unroll") for (int w4 = 0; w4 < 4; ++w4) { s += P[(tid * 4 + w4) * 2]; q += P[(tid * 4 + w4) * 2 + 1]; }
        const unsigned long long v = ((unsigned long long)__float_as_uint(q) << 32) | __float_as_uint(s);
        __hip_atomic_store(xs + (long)(d.brow + tid) * 4 + d.aux, v, __ATOMIC_RELAXED, __HIP_MEMORY_SCOPE_AGENT); }
      asm volatile("s_waitcnt vmcnt(0)" ::: "memory");
      __syncthreads();
      if (tid == 0) { unsigned* c = pcnt + (d.brow >> 8) * 16; __hip_atomic_fetch_add(c, 1u, __ATOMIC_RELAXED, __HIP_MEMORY_SCOPE_AGENT);
        const unsigned target = 4u * (unsigned)(seq + 1); unsigned sp = 0;
        while (__hip_atomic_load(c, __ATOMIC_RELAXED, __HIP_MEMORY_SCOPE_AGENT) < target) { __builtin_amdgcn_s_sleep(1); if (++sp > (1u << 22)) break; } }
      asm volatile("s_waitcnt vmcnt(0)" ::: "memory");
      __syncthreads();
      if (tid < 256) { float s = 0.f, q = 0.f;
        _Pragma("unroll") for (int pn = 0; pn < 4; ++pn) { const unsigned long long v = __hip_atomic_load(xs + (long)(d.brow + tid) * 4 + pn, __ATOMIC_RELAXED, __HIP_MEMORY_SCOPE_AGENT);
          s += __uint_as_float((unsigned)v); q += __uint_as_float((unsigned)(v >> 32)); }
        const float mu = s * (1.0f / 1024.0f), var = q * (1.0f / 1024.0f) - mu * mu;
        P[tid * 2] = mu; P[tid * 2 + 1] = rsqrtf(var + 1e-5f); }
      __syncthreads();
      EPI_ROWS { const int rl = ai * 128 + wr * 64 + m * 16 + fr; const long row = d.brow + rl; const float mu = P[rl * 2], rs = P[rl * 2 + 1];
        EPI_BJ { const int col = d.bcol + bj * 128 + wc * 32 + fq * 8; const long o = row * 1024 + col;
          const f4 g0 = *(const f4*)(lng + col), g1 = *(const f4*)(lng + col + 4), b0 = *(const f4*)(lnb + col), b1 = *(const f4*)(lnb + col + 4); f4 v0, v1;
          _Pragma("unroll") for (int j = 0; j < 4; ++j) { v0[j] = (acc[ai][bj][m][0][j] - mu) * rs * g0[j] + b0[j]; v1[j] = (acc[ai][bj][m][1][j] - mu) * rs * g1[j] + b1[j]; }
          *(h8*)(x16 + o) = cvt8(v0, v1);
          if (out32) { *(f4*)(out32 + o) = v0; *(f4*)(out32 + o + 4) = v1; } } }
      __syncthreads();
    });
}

__device__ __forceinline__ void phase_mix_a(KP p) {
  gemm_stream([&](int i, GU& d) AINL -> bool { int pm, pn; if (!tile_order(i, 128, 15, pm, pn)) return false; KP q = getp(); set_gu(d, q->x16, 1024, q->wmix, 1024, 1024, pm * 256, pn * 256, pn); return true; },
    [&](EPI_ARGS) AINL {
      const int pn = d.aux; hf* dst; int ldc, coff; KP q = getp();
      if (pn < 2) { dst = q->aq; ldc = 512; coff = pn * 256; }
      else if (pn == 2) { dst = q->akv; ldc = 256; coff = 0; }
      else if (pn < 5) { dst = q->dq; ldc = 512; coff = (pn - 3) * 256; }
      else if (pn < 7) { dst = q->dk; ldc = 512; coff = (pn - 5) * 256; }
      else if (pn < 9) { dst = q->dv; ldc = 512; coff = (pn - 7) * 256; }
      else if (pn < 11) { dst = q->su; ldc = 512; coff = (pn - 9) * 256; }
      else { dst = q->cu; ldc = 1024; coff = (pn - 11) * 256; }
      EPI_ROWS { const long row = d.brow + ai * 128 + wr * 64 + m * 16 + fr;
        EPI_BJ { *(h8*)(dst + row * ldc + coff + bj * 128 + wc * 32 + fq * 8) = cvt8(acc[ai][bj][m][0], acc[ai][bj][m][1]); } } });
}

__device__ __forceinline__ void phase_plain(const hf* A, int lda, const hf* Wt, int K, hf* dst, int ldc, int nM, int nN) {
  gemm_stream([&](int i, GU& d) AINL -> bool { int pm, pn; if (!tile_order(i, nM, nN, pm, pn)) return false; set_gu(d, A, lda, Wt, K, K, pm * 256, pn * 256, 0); return true; },
    [&](EPI_ARGS) AINL {
      EPI_ROWS { const long row = d.brow + ai * 128 + wr * 64 + m * 16 + fr;
        EPI_BJ { *(h8*)(dst + row * ldc + d.bcol + bj * 128 + wc * 32 + fq * 8) = cvt8(acc[ai][bj][m][0], acc[ai][bj][m][1]); } } });
}

__device__ __forceinline__ void phase_s5_glu(KP p, int l) {
  const float* gb = p->in[18] + l * 512; const hf* y = p->s5tmp; hf* dst = p->su; const hf* glu = p->glu;
  gemm_stream([&](int i, GU& d) AINL -> bool { int pm, pn; if (!tile_order(i, 128, 2, pm, pn)) return false; set_gu(d, y, 512, glu, 512, 512, pm * 256, pn * 256, 0); return true; },
    [&](EPI_ARGS) AINL {
      EPI_ROWS { const long row = d.brow + ai * 128 + wr * 64 + m * 16 + fr;
        EPI_BJ { const int col = d.bcol + bj * 128 + wc * 32 + fq * 8;
          const h8 yy = *(const h8*)(y + row * 512 + col); const f4 b0 = *(const f4*)(gb + col), b1 = *(const f4*)(gb + col + 4); f4 v0 = acc[ai][bj][m][0], v1 = acc[ai][bj][m][1];
          _Pragma("unroll") for (int j = 0; j < 4; ++j) { v0[j] = (float)yy[j] * sigmoidf_(v0[j] + b0[j]); v1[j] = (float)yy[4 + j] * sigmoidf_(v1[j] + b1[j]); }
          *(h8*)(dst + row * 512 + col) = cvt8(v0, v1); } } });
}

__device__ __forceinline__ void phase_merge(KP p) {
  gemm_stream([&](int idx, GU& d) AINL -> bool {
      const int it = idx >> 3, s = idx & 7, i = s >> 1; int pm, pn; if (!tile_order(it, 128, 4, pm, pn)) return false;
      KP q = getp();
      if ((s & 1) == 1) set_gu(d, q->x16, 1024, q->wmix + (size_t)(3840 + i * 1024) * 1024, 1024, 1024, pm * 256, pn * 256, s);
      else { const hf* A = i == 0 ? q->swo : i == 1 ? q->su : i == 2 ? q->convout : q->dfo; const hf* W = i == 0 ? q->pswa : i == 1 ? q->ps5 : i == 2 ? q->pconv : q->pdiff;
        set_gu(d, A, 512, W, 512, 512, pm * 256, pn * 256, s); }
      return true; },
    [&](EPI_ARGS) AINL {
      const int s = d.aux; KP q = getp(); hf* ybuf = q->dk; hf* merged = q->cu;
      if ((s & 1) == 0) {
        EPI_ROWS { const long row = d.brow + ai * 128 + wr * 64 + m * 16 + fr;
          EPI_BJ { *(h8*)(ybuf + row * 1024 + d.bcol + bj * 128 + wc * 32 + fq * 8) = cvt8(acc[ai][bj][m][0], acc[ai][bj][m][1]); } }
      } else {
        EPI_ROWS { const long row = d.brow + ai * 128 + wr * 64 + m * 16 + fr;
          EPI_BJ { const long o = row * 1024 + d.bcol + bj * 128 + wc * 32 + fq * 8;
            const h8 y = *(const h8*)(ybuf + o); h8 mo; if (s > 1) mo = *(const h8*)(merged + o);
            f4 v0 = acc[ai][bj][m][0], v1 = acc[ai][bj][m][1];
            _Pragma("unroll") for (int j = 0; j < 4; ++j) { v0[j] = sigmoidf_(v0[j]) * (float)y[j]; v1[j] = sigmoidf_(v1[j]) * (float)y[4 + j]; }
            if (s > 1) { _Pragma("unroll") for (int j = 0; j < 4; ++j) { v0[j] += (float)mo[j]; v1[j] += (float)mo[4 + j]; } }
            *(h8*)(merged + o) = cvt8(v0, v1); } }
      } });
}

__device__ __forceinline__ float wave_sum(float v) {
  for (int o = 32; o > 0; o >>= 1) v += __shfl_xor(v, o);
  return v;
}

__device__ __forceinline__ void ln_rows(const float* src, const float* g, const float* b, float* dst32, hf* dst16, int nrows) {
  const int wave = blockIdx.x * 8 + (tidx() >> 6), nw = gridDim.x * 8, lane = tidx() & 63;
  f4 gg[4], bb[4];
  for (int i = 0; i < 4; ++i) { gg[i] = *(const f4*)(g + i * 256 + lane * 4); bb[i] = *(const f4*)(b + i * 256 + lane * 4); }
  for (int r = wave; r < nrows; r += nw) {
    f4 v[4]; float s = 0.f;
    for (int i = 0; i < 4; ++i) { v[i] = *(const f4*)(src + (long)r * 1024 + i * 256 + lane * 4); s += (v[i][0] + v[i][1]) + (v[i][2] + v[i][3]); }
    const float mu = wave_sum(s) * (1.0f / 1024.0f);
    float q = 0.f;
    for (int i = 0; i < 4; ++i) for (int j = 0; j < 4; ++j) { const float d = v[i][j] - mu; q += d * d; }
    const float rs = rsqrtf(wave_sum(q) * (1.0f / 1024.0f) + 1e-5f);
    for (int i = 0; i < 4; ++i) { f4 o; for (int j = 0; j < 4; ++j) o[j] = (v[i][j] - mu) * rs * gg[i][j] + bb[i][j];
      if (dst32) *(f4*)(dst32 + (long)r * 1024 + i * 256 + lane * 4) = o;
      *(h4*)(dst16 + (long)r * 1024 + i * 256 + lane * 4) = cvt4(o); }
  }
}

__device__ __forceinline__ void ln_rows16(const hf* src, const float* g, const float* b, float* dst32, hf* dst16, int nrows) {
  const int wave = blockIdx.x * 8 + (tidx() >> 6), nw = gridDim.x * 8, lane = tidx() & 63;
  f4 gg[4], bb[4];
  for (int i = 0; i < 4; ++i) { gg[i] = *(const f4*)(g + i * 256 + lane * 4); bb[i] = *(const f4*)(b + i * 256 + lane * 4); }
  for (int r = wave; r < nrows; r += nw) {
    f4 v[4]; float s = 0.f;
    for (int i = 0; i < 4; ++i) { const h4 t = *(const h4*)(src + (long)r * 1024 + i * 256 + lane * 4); v[i][0] = (float)t[0]; v[i][1] = (float)t[1]; v[i][2] = (float)t[2]; v[i][3] = (float)t[3];
      s += (v[i][0] + v[i][1]) + (v[i][2] + v[i][3]); }
    const float mu = wave_sum(s) * (1.0f / 1024.0f);
    float q = 0.f;
    for (int i = 0; i < 4; ++i) for (int j = 0; j < 4; ++j) { const float d = v[i][j] - mu; q += d * d; }
    const float rs = rsqrtf(wave_sum(q) * (1.0f / 1024.0f) + 1e-5f);
    for (int i = 0; i < 4; ++i) { f4 o; for (int j = 0; j < 4; ++j) o[j] = (v[i][j] - mu) * rs * gg[i][j] + bb[i][j];
      if (dst32) *(f4*)(dst32 + (long)r * 1024 + i * 256 + lane * 4) = o;
      *(h4*)(dst16 + (long)r * 1024 + i * 256 + lane * 4) = cvt4(o); }
  }
}

__device__ __forceinline__ void conv_w_job(const float* __restrict__ src, int ld, int K, hf* __restrict__ dst, int NBk  , int mode, int coloff) {
  float* tile = (float*)smem;
  const int nkb = K / 64, total = NBk * nkb, tid = tidx();
  for (int u = blockIdx.x; u < total; u += gridDim.x) {
    const int nb = u / nkb, kb = u % nkb;
    int c0;
    if (mode == 0) c0 = coloff + nb * 64;
    else { const int j = nb >> 2, sub = nb & 3; c0 = (sub < 2) ? (j * 128 + sub * 64) : (FFN + j * 128 + (sub - 2) * 64); }
    __syncthreads();
    for (int h = 0; h < 2; ++h) { const int kk = (tid >> 4) + h * 32, c4 = tid & 15;
      const f4 v = *(const f4*)(src + (long)(kb * 64 + kk) * ld + c0 + c4 * 4);
      for (int j = 0; j < 4; ++j) tile[kk * 65 + c4 * 4 + j] = v[j]; }
    __syncthreads();
    { const int n = tid >> 3, k8 = tid & 7; h8 o;
      const int rho = n & 31, ii = rho & 15, ns = (n & 32) + 8 * (ii >> 2) + 4 * (rho >> 4) + (ii & 3);
      for (int j = 0; j < 8; ++j) o[j] = (hf)tile[(k8 * 8 + j) * 65 + ns];
      *(h8*)(dst + (long)(nb * 64 + n) * K + kb * 64 + k8 * 8) = o; }
  }
}

__device__ __forceinline__ void convert_ffn(KP p, const float* w_in, const float* w_out, hf* din, hf* dout) {
  conv_w_job(w_in, 2 * FFN, 1024, din, 88, 1, 0);
  conv_w_job(w_out, 1024, FFN, dout, 16, 0, 0);
}
__device__ __forceinline__ void convert_mix(KP p, int l) {
  conv_w_job(p->in[6] + (long)l * 1024 * 7936, 7936, 1024, p->wmix, 124, 0, 0);
  conv_w_job(p->in[8] + (long)l * 512 * 1024, 1024, 512, p->pswa, 16, 0, 0);
  conv_w_job(p->in[19] + (long)l * 512 * 1024, 1024, 512, p->ps5, 16, 0, 0);
  conv_w_job(p->in[24] + (long)l * 512 * 1024, 1024, 512, p->pconv, 16, 0, 0);
  conv_w_job(p->in[30] + (long)l * 512 * 1024, 1024, 512, p->pdiff, 16, 0, 0);
  conv_w_job(p->in[17] + (long)l * 512 * 512, 512, 512, p->glu, 8, 0, 0);
  conv_w_job(p->in[31] + (long)l * 1024 * 1024, 1024, 1024, p->wout, 16, 0, 0);
}
__device__ __forceinline__ void convert_cross(KP p, int l) {
  conv_w_job(p->in[36] + (long)l * 1024 * 512, 512, 1024, p->wq, 8, 0, 0);
  conv_w_job(p->in[38] + (long)l * 512 * 1024, 1024, 512, p->wo, 16, 0, 0);
}

__device__ __forceinline__ void phase_init(KP p) {
  { const long n4 = (long)NTOK * 1024 / 4; const f4* s = (const f4*)p->in[0]; h4* d = (h4*)p->x16;
    for (long i = (long)blockIdx.x * 512 + tidx(); i < n4; i += (long)gridDim.x * 512) d[i] = cvt4(s[i]); }
  ln_rows(p->in[1], p->in[34], p->in[35], nullptr, p->memn, 4096);
  convert_ffn(p, p->in[2], p->in[3], p->wbin, p->wbout);
  for (int l = 0; l < 4; ++l) conv_w_job(p->in[37] + (long)l * 1024 * 1024, 1024, 1024, p->wkv + (long)l * 1024 * 1024, 16, 0, 0);
}

__device__ __forceinline__ h4 trrd(const hf* q) { return __builtin_bit_cast(h4, __builtin_amdgcn_ds_read_tr16_b64_v4i16((__attribute__((address_space(3))) s4v*)q)); }

template <int DK, int DV, int KW, bool ALIBI, int MASK>
__device__ __forceinline__ void attn_core(const hf* __restrict__ Kg, long kstride, const hf* __restrict__ Vg, long vstride, int T0, int T1,
                                          const hf* __restrict__ Qw, long qstride, int kcol, int q0, float c1, float c2,
                                          f4 (&O)[2][DV / 16], float (&m)[2], float (&l)[2]) {
  constexpr int KSTR = KW + 8, VSTR = DV + 8, KCH = KW / 8, VCH = DV / 8, NKL = 64 * KCH / 512, NVL = 64 * VCH / 512;
  hf* Ks = (hf*)smem; hf* Vs = Ks + 64 * KSTR;
  const int tid = tidx(), lane = tid & 63, fr = lane & 15, fq = lane >> 4;
  h8 qf[2][DK / 32];
#pragma unroll
  for (int qs = 0; qs < 2; ++qs)
#pragma unroll
    for (int ks = 0; ks < DK / 32; ++ks) qf[qs][ks] = *(const h8*)(Qw + (long)(qs * 16 + fr) * qstride + ks * 32 + fq * 8);
  h8 kreg[NKL], vreg[NVL];
#pragma unroll
  for (int i = 0; i < NKL; ++i) { const int idx = tid + i * 512, r = idx / KCH, c = idx % KCH; kreg[i] = *(const h8*)(Kg + (long)(T0 * 64 + r) * kstride + c * 8); }
#pragma unroll
  for (int i = 0; i < NVL; ++i) { const int idx = tid + i * 512, r = idx / VCH, c = idx % VCH; vreg[i] = *(const h8*)(Vg + (long)(T0 * 64 + r) * vstride + c * 8); }
#pragma unroll 1
  for (int T = T0; T < T1; ++T) {
    __syncthreads();
#pragma unroll
    for (int i = 0; i < NKL; ++i) { const int idx = tid + i * 512, r = idx / KCH, c = idx % KCH; *(h8*)(Ks + r * KSTR + c * 8) = kreg[i]; }
#pragma unroll
    for (int i = 0; i < NVL; ++i) { const int idx = tid + i * 512, r = idx / VCH, c = idx % VCH; *(h8*)(Vs + r * VSTR + c * 8) = vreg[i]; }
    __syncthreads();
    if (T + 1 < T1) {
#pragma unroll
      for (int i = 0; i < NKL; ++i) { const int idx = tid + i * 512, r = idx / KCH, c = idx % KCH; kreg[i] = *(const h8*)(Kg + (long)((T + 1) * 64 + r) * kstride + c * 8); }
#pragma unroll
      for (int i = 0; i < NVL; ++i) { const int idx = tid + i * 512, r = idx / VCH, c = idx % VCH; vreg[i] = *(const h8*)(Vg + (long)((T + 1) * 64 + r) * vstride + c * 8); }
    }
    bool rel = true;
    if (MASK >= 1) rel = (T * 64 <= q0 + 31);
    if (MASK == 2) rel = rel && (T * 64 + 63 >= q0 - 127);
    if (rel) {
      f4 S[2][4];
#pragma unroll
      for (int kt = 0; kt < 4; ++kt) {
#pragma unroll
        for (int qs = 0; qs < 2; ++qs) S[qs][kt] = (f4){0.f, 0.f, 0.f, 0.f};
#pragma unroll
        for (int ks = 0; ks < DK / 32; ++ks) {
          const h8 kf = *(const h8*)(Ks + (kt * 16 + fr) * KSTR + kcol + ks * 32 + fq * 8);
#pragma unroll
          for (int qs = 0; qs < 2; ++qs) S[qs][kt] = __builtin_amdgcn_mfma_f32_16x16x32_f16(kf, qf[qs][ks], S[qs][kt], 0, 0, 0);
        }
      }
      h8 pf[2][2];
#pragma unroll
      for (int qs = 0; qs < 2; ++qs) {
        const int qp = q0 + qs * 16 + fr;
        float mx = m[qs];
        const float abase = ALIBI ? c2 * (float)(T * 64 + fq * 4 - qp) : 0.f;
        const bool need_mask = (MASK == 2) || (MASK == 1 && (T * 64 + 63 > q0));
        if (need_mask) {
#pragma unroll
          for (int kt = 0; kt < 4; ++kt)
#pragma unroll
            for (int jj = 0; jj < 4; ++jj) {
              const int kp = T * 64 + kt * 16 + fq * 4 + jj;
              float s = fmaf(S[qs][kt][jj], c1, ALIBI ? fmaf(c2, (float)(kt * 16 + jj), abase) : 0.f);
              if (MASK == 1) s = (kp <= qp) ? s : -1e30f;
              if (MASK == 2) s = (kp <= qp && qp - kp < 128) ? s : -1e30f;
              S[qs][kt][jj] = s; mx = fmaxf(mx, s);
            }
        } else {
#pragma unroll
          for (int kt = 0; kt < 4; ++kt)
#pragma unroll
            for (int jj = 0; jj < 4; ++jj) {
              const float s = fmaf(S[qs][kt][jj], c1, ALIBI ? fmaf(c2, (float)(kt * 16 + jj), abase) : 0.f);
              S[qs][kt][jj] = s; mx = fmaxf(mx, s);
            }
        }
        mx = fmaxf(mx, __shfl_xor(mx, 16)); mx = fmaxf(mx, __shfl_xor(mx, 32));
        const float alpha = __builtin_amdgcn_exp2f(m[qs] - mx); m[qs] = mx;
        float ps = 0.f;
#pragma unroll
        for (int kt = 0; kt < 4; ++kt)
#pragma unroll
          for (int jj = 0; jj < 4; ++jj) { const float pv = __builtin_amdgcn_exp2f(S[qs][kt][jj] - mx); ps += pv; S[qs][kt][jj] = pv; }
        l[qs] = l[qs] * alpha + ps;
#pragma unroll
        for (int et = 0; et < DV / 16; ++et) O[qs][et] *= alpha;
#pragma unroll
        for (int pr = 0; pr < 2; ++pr)
#pragma unroll
          for (int jj = 0; jj < 4; ++jj) { pf[qs][pr][jj] = (hf)S[qs][2 * pr][jj]; pf[qs][pr][4 + jj] = (hf)S[qs][2 * pr + 1][jj]; }
      }
#pragma unroll
      for (int pr = 0; pr < 2; ++pr)
#pragma unroll
        for (int et = 0; et < DV / 16; ++et) {
          const h4 v0 = trrd(Vs + (pr * 32 + fq * 4 + (fr >> 2)) * VSTR + et * 16 + (fr & 3) * 4);
          const h4 v1 = trrd(Vs + (pr * 32 + 16 + fq * 4 + (fr >> 2)) * VSTR + et * 16 + (fr & 3) * 4);
          h8 vf; vf[0] = v0[0]; vf[1] = v0[1]; vf[2] = v0[2]; vf[3] = v0[3]; vf[4] = v1[0]; vf[5] = v1[1]; vf[6] = v1[2]; vf[7] = v1[3];
#pragma unroll
          for (int qs = 0; qs < 2; ++qs) O[qs][et] = __builtin_amdgcn_mfma_f32_16x16x32_f16(vf, pf[qs][pr], O[qs][et], 0, 0, 0);
        }
    }
  }
}

__device__ __forceinline__ void swa_unit(KP p, int l, int u) {
  const int hp = u & 1, n = (u >> 1) & 15, g = (u >> 5) & 1, b = u >> 6;
  const int w = tidx() >> 6, lane = tidx() & 63, fr = lane & 15, fq = lane >> 4;
  const int hq = g * 4 + hp * 2 + (w >> 2), q0 = n * 128 + (w & 3) * 32;
  const hf* Kg = p->akv + (long)b * SEQ * 256 + g * 64; const hf* Vg = Kg + 128;
  hf* Qw = p->aq + ((long)b * SEQ + q0) * 512 + hq * 64;
  hf* Ow = p->swo + ((long)b * SEQ + q0) * 512 + hq * 64;
  const float slope = exp2f(-(float)(hq + 1));
  f4 O[2][4]; float m[2], ls[2];
  const float sink = p->in[7][l * 8 + hq] * LOG2E;
  for (int qs = 0; qs < 2; ++qs) { m[qs] = sink; ls[qs] = (fq == 0) ? 1.f : 0.f; for (int et = 0; et < 4; ++et) O[qs][et] = (f4){0.f, 0.f, 0.f, 0.f}; }
  const int T0 = (2 * n - 2) < 0 ? 0 : (2 * n - 2), T1 = 2 * n + 2;
  attn_core<64, 64, 64, true, 2>(Kg, 256, Vg, 256, T0, T1, Qw, 512, 0, q0, 0.125f * LOG2E, slope * LOG2E, O, m, ls);
  for (int qs = 0; qs < 2; ++qs) {
    float lt = ls[qs]; lt += __shfl_xor(lt, 16); lt += __shfl_xor(lt, 32);
    const float inv = 1.0f / lt;
    for (int et = 0; et < 4; ++et) *(h4*)(Ow + (long)(qs * 16 + fr) * 512 + et * 16 + fq * 4) = cvt4(O[qs][et] * inv);
  }
}

__device__ __forceinline__ void diff_unit(KP p, int l, int u) {
  const int n = 15 - (u >> 6), h = u & 3, b = (u >> 2) & 15;
  const int w = tidx() >> 6, lane = tidx() & 63, fr = lane & 15, fq = lane >> 4;
  const int comp = w & 1, q0 = n * 128 + (w >> 1) * 32;
  const hf* Kg = p->dk + (long)b * SEQ * 512 + h * 128; const hf* Vg = p->dv + (long)b * SEQ * 512 + h * 128;
  hf* Qrow = p->dq + ((long)b * SEQ + q0) * 512 + h * 128;
  hf* Orow = p->dfo + ((long)b * SEQ + q0) * 512 + h * 128;
  const float slope = exp2f(-2.0f * (float)(h + 1));
  const float lambda_init = 0.8f - 0.6f * expf(-0.3f * (float)l);
  float lam;
  { const float a = p->in[25][l * 64 + lane] * p->in[26][l * 64 + lane], c = p->in[27][l * 64 + lane] * p->in[28][l * 64 + lane];
    lam = expf(wave_sum(a)) - expf(wave_sum(c)) + lambda_init; }
  f4 O[2][8]; float m[2], ls[2];
  for (int qs = 0; qs < 2; ++qs) { m[qs] = -1e30f; ls[qs] = 0.f; for (int et = 0; et < 8; ++et) O[qs][et] = (f4){0.f, 0.f, 0.f, 0.f}; }
  attn_core<64, 128, 128, true, 1>(Kg, 512, Vg, 512, 0, 2 * n + 2, Qrow + comp * 64, 512, comp * 64, q0, 0.125f * LOG2E, slope * LOG2E, O, m, ls);
  float inv[2];
  for (int qs = 0; qs < 2; ++qs) { float lt = ls[qs]; lt += __shfl_xor(lt, 16); lt += __shfl_xor(lt, 32); inv[qs] = 1.0f / lt; }
  __syncthreads();
  float* XS = (float*)smem + (w >> 1) * 4096;
  if (comp == 1) {
    for (int qs = 0; qs < 2; ++qs) for (int et = 0; et < 8; ++et) for (int jj = 0; jj < 4; ++jj) XS[((qs * 8 + et) * 4 + jj) * 64 + lane] = O[qs][et][jj] * inv[qs];
  }
  __syncthreads();
  if (comp == 0) {
    const float* ng = p->in[29] + l * 128;
    for (int qs = 0; qs < 2; ++qs) {
      float ss = 0.f;
      for (int et = 0; et < 8; ++et) for (int jj = 0; jj < 4; ++jj) { const float v = O[qs][et][jj] * inv[qs] - lam * XS[((qs * 8 + et) * 4 + jj) * 64 + lane]; O[qs][et][jj] = v; ss += v * v; }
      ss += __shfl_xor(ss, 16); ss += __shfl_xor(ss, 32);
      const float r = rsqrtf(ss * (1.0f / 128.0f) + 1e-5f) * (1.0f - lambda_init);
      for (int et = 0; et < 8; ++et) { const f4 g4 = *(const f4*)(ng + et * 16 + fq * 4); f4 v = O[qs][et];
        for (int jj = 0; jj < 4; ++jj) v[jj] = v[jj] * r * g4[jj];
        *(h4*)(Orow + (long)(qs * 16 + fr) * 512 + et * 16 + fq * 4) = cvt4(v); }
    }
  }
}

__device__ __forceinline__ void cross_unit(KP p, int l, int u) {
  const int qb = u & 7, h = (u >> 3) & 3, b = u >> 5;
  const int w = tidx() >> 6, lane = tidx() & 63, fr = lane & 15, fq = lane >> 4;
  const int q0 = qb * 256 + w * 32;
  const hf* Kg = p->kvc + (long)l * 4096 * 1024 + (long)b * 256 * 1024 + h * 128; const hf* Vg = Kg + 512;
  const hf* Qw = p->aq + ((long)b * SEQ + q0) * 512 + h * 128;
  hf* Ow = p->dq + ((long)b * SEQ + q0) * 512 + h * 128;
  f4 O[2][8]; float m[2], ls[2];
  for (int qs = 0; qs < 2; ++qs) { m[qs] = -1e30f; ls[qs] = 0.f; for (int et = 0; et < 8; ++et) O[qs][et] = (f4){0.f, 0.f, 0.f, 0.f}; }
  attn_core<128, 128, 128, false, 0>(Kg, 1024, Vg, 1024, 0, 4, Qw, 512, 0, q0, 0.08838834764831845f * LOG2E, 0.f, O, m, ls);
  for (int qs = 0; qs < 2; ++qs) {
    float lt = ls[qs]; lt += __shfl_xor(lt, 16); lt += __shfl_xor(lt, 32);
    const float inv = 1.0f / lt;
    for (int et = 0; et < 8; ++et) *(h4*)(Ow + (long)(qs * 16 + fr) * 512 + et * 16 + fq * 4) = cvt4(O[qs][et] * inv);
  }
}

__device__ __forceinline__ void s5_unit(KP p, int l, int u) {
  const int b = u >> 2, w = tidx() >> 6, g = (u & 3) * 8 + w, lane = tidx() & 63, fr = lane & 15, fq = lane >> 4;
  float* BuS = (float*)(smem + w * 12800);
  float* Yt = BuS + 16 * 132;
  const int lg = l * 32 + g;
  const float step = expf(p->in[11][lg]);
  float abr, abi;
  { const float ar = p->in[9][lg * 64 + lane], ai = p->in[10][lg * 64 + lane]; const float mag = expf(ar * step); abr = mag * cosf(ai * step); abi = mag * sinf(ai * step); }
  h8 bfr[8];
#pragma unroll
  for (int nt = 0; nt < 8; ++nt) {
    const int pp = (nt & 3) * 16 + fr;
    const float ar = p->in[9][lg * 64 + pp], ai = p->in[10][lg * 64 + pp]; const float mag = expf(ar * step);
    const float nr = mag * cosf(ai * step) - 1.0f, ni = mag * sinf(ai * step), den = ar * ar + ai * ai;
    const float cr = (nr * ar + ni * ai) / den, ci = (ni * ar - nr * ai) / den;
    const float* brp = p->in[12] + ((long)lg * 64 + pp) * 16 + (fq & 1) * 8; const float* bip = p->in[13] + ((long)lg * 64 + pp) * 16 + (fq & 1) * 8;
#pragma unroll
    for (int s = 0; s < 8; ++s) { const float v = (nt < 4) ? (cr * brp[s] - ci * bip[s]) : (cr * bip[s] + ci * brp[s]); bfr[nt][s] = (fq < 2) ? (hf)v : (hf)0.0f; }
  }
  h8 cfr[4];
#pragma unroll
  for (int ks = 0; ks < 4; ++ks) {
    const float* src = (ks < 2 ? p->in[14] : p->in[15]) + ((long)lg * 16 + fr) * 64 + (ks & 1) * 32 + fq * 8;
    const float sg = ks < 2 ? 1.0f : -1.0f;
#pragma unroll
    for (int j = 0; j < 8; ++j) cfr[ks][j] = (hf)(sg * src[j]);
  }
  h8 dfr;
  { const float dd = p->in[16][l * 512 + g * 16 + fr];
#pragma unroll
    for (int s = 0; s < 8; ++s) dfr[s] = (fq < 2 && (fq & 1) * 8 + s == fr) ? (hf)dd : (hf)0.0f; }
  float xr = 0.f, xi = 0.f;
  const hf* up = p->su + (long)b * SEQ * 512 + g * 16 + (fq & 1) * 8;
  hf* yp = p->s5tmp + (long)b * SEQ * 512 + g * 16;
  h8 un = *(const h8*)(up + (long)fr * 512);
#pragma unroll 1
  for (int ch = 0; ch < 128; ++ch) {
    h8 uf = un;
    if (fq >= 2) { for (int s = 0; s < 8; ++s) uf[s] = (hf)0.0f; }
    if (ch < 127) un = *(const h8*)(up + (long)((ch + 1) * 16 + fr) * 512);
#pragma unroll
    for (int nt = 0; nt < 8; ++nt) {
      const f4 d = __builtin_amdgcn_mfma_f32_16x16x32_f16(uf, bfr[nt], (f4){0.f, 0.f, 0.f, 0.f}, 0, 0, 0);
#pragma unroll
      for (int jj = 0; jj < 4; ++jj) BuS[(fq * 4 + jj) * 132 + nt * 16 + fr] = d[jj];
    }
    __syncthreads();
    float br_[16], bi_[16];
#pragma unroll
    for (int t = 0; t < 16; ++t) { br_[t] = BuS[t * 132 + lane]; bi_[t] = BuS[t * 132 + 64 + lane]; }
#pragma unroll
    for (int t = 0; t < 16; ++t) {
      const float nxr = abr * xr - abi * xi + br_[t], nxi = abr * xi + abi * xr + bi_[t]; xr = nxr; xi = nxi;
      BuS[t * 132 + lane] = xr; BuS[t * 132 + 64 + lane] = xi;
    }
    __syncthreads();
    f4 y = (f4){0.f, 0.f, 0.f, 0.f};
#pragma unroll
    for (int ks = 0; ks < 4; ++ks) {
      const f4 xa = *(const f4*)(BuS + fr * 132 + ks * 32 + fq * 8), xb = *(const f4*)(BuS + fr * 132 + ks * 32 + fq * 8 + 4);
      h8 xf; xf[0] = (hf)xa[0]; xf[1] = (hf)xa[1]; xf[2] = (hf)xa[2]; xf[3] = (hf)xa[3]; xf[4] = (hf)xb[0]; xf[5] = (hf)xb[1]; xf[6] = (hf)xb[2]; xf[7] = (hf)xb[3];
      y = __builtin_amdgcn_mfma_f32_16x16x32_f16(xf, cfr[ks], y, 0, 0, 0);
    }
    y = __builtin_amdgcn_mfma_f32_16x16x32_f16(uf, dfr, y, 0, 0, 0);
#pragma unroll
    for (int jj = 0; jj < 4; ++jj) {
      const float v = y[jj], z = 0.7978845608028654f * (v + 0.044715f * v * v * v);
      const float th = 1.0f - 2.0f * __builtin_amdgcn_rcpf(__builtin_amdgcn_exp2f(2.8853900817779268f * z) + 1.0f);
      Yt[(fq * 4 + jj) * 20 + fr] = 0.5f * v * (1.0f + th);
    }
    __syncthreads();
    { const int t = lane >> 2, c4 = (lane & 3) * 4; const f4 v = *(const f4*)(Yt + t * 20 + c4);
      *(h4*)(yp + (long)(ch * 16 + t) * 512 + c4) = cvt4(v); }
  }
}

__device__ __forceinline__ void conv_unit(KP p, int l, int u) {
  const int b = u >> 5, t0 = (u & 31) * 64, tid = tidx(), w = tid >> 6, lane = tid & 63;
  hf* G = (hf*)smem;
  hf* Wc = (hf*)(smem + 96256);
  for (int idx = tid; idx < 94 * 64; idx += 512) {
    const int r = idx >> 6, c8 = idx & 63, t = t0 - 30 + r; h8 o;
    if (t >= 0) { const hf* src = p->cu + ((long)b * SEQ + t) * 1024 + c8 * 8; const h8 v = *(const h8*)src, gt = *(const h8*)(src + 512);
      for (int j = 0; j < 8; ++j) o[j] = (hf)((float)v[j] * sigmoidf_((float)gt[j])); }
    else { for (int j = 0; j < 8; ++j) o[j] = (hf)0.0f; }
    *(h8*)(G + r * 512 + c8 * 8) = o;
  }
  { const float* cw = p->in[20] + (long)l * 31 * 512; for (int idx = tid; idx < 31 * 512; idx += 512) Wc[idx] = (hf)cw[idx]; }
  __syncthreads();
  const float* cb = p->in[21] + l * 512 + lane * 8; const f4 b0 = *(const f4*)cb, b1 = *(const f4*)(cb + 4);
  const float* lg = p->in[22] + l * 512 + lane * 8; const float* lb = p->in[23] + l * 512 + lane * 8;
  const f4 g0 = *(const f4*)lg, g1 = *(const f4*)(lg + 4), c0 = *(const f4*)lb, c1 = *(const f4*)(lb + 4);
#pragma unroll 1
  for (int jp = 0; jp < 4; ++jp) {
    float a0[8], a1[8];
#pragma unroll
    for (int c = 0; c < 8; ++c) { a0[c] = c < 4 ? b0[c & 3] : b1[c & 3]; a1[c] = a0[c]; }
    const hf* gp = G + (w * 8 + jp * 2) * 512 + lane * 8;
    h8 wprev;
#pragma unroll
    for (int c = 0; c < 8; ++c) wprev[c] = (hf)0.0f;
#pragma unroll 8
    for (int k = 0; k < 32; ++k) {
      const h8 gv = *(const h8*)(gp + k * 512);
      h8 wv;
      if (k < 31) wv = *(const h8*)(Wc + k * 512 + lane * 8); else { for (int c = 0; c < 8; ++c) wv[c] = (hf)0.0f; }
#pragma unroll
      for (int c = 0; c < 8; ++c) { a0[c] += (float)gv[c] * (float)wv[c]; a1[c] += (float)gv[c] * (float)wprev[c]; }
      wprev = wv;
    }
#pragma unroll
    for (int jj = 0; jj < 2; ++jj) {
      float s = 0.f;
#pragma unroll
      for (int c = 0; c < 8; ++c) s += jj ? a1[c] : a0[c];
      const float mu = wave_sum(s) * (1.0f / 512.0f);
      float q = 0.f;
#pragma unroll
      for (int c = 0; c < 8; ++c) { const float d = (jj ? a1[c] : a0[c]) - mu; q += d * d; }
      const float rs = rsqrtf(wave_sum(q) * (1.0f / 512.0f) + 1e-5f);
      h8 o;
#pragma unroll
      for (int c = 0; c < 8; ++c) { const float gg = c < 4 ? g0[c & 3] : g1[c & 3], bb = c < 4 ? c0[c & 3] : c1[c & 3];
        const float v = ((jj ? a1[c] : a0[c]) - mu) * rs * gg + bb; o[c] = (hf)(v * sigmoidf_(v)); }
      *(h8*)(p->convout + ((long)b * SEQ + t0 + w * 8 + jp * 2 + jj) * 512 + lane * 8) = o;
    }
  }
}

__device__ __forceinline__ void phase_mixers(KP p, int l, int cidx) {
  volatile int* ctl = (volatile int*)(smem + CTL_OFF);
  const int NS5 = 64, NDIFF = 1024, NSWA = 1024, NCONV = 512, TOTAL = NS5 + NDIFF + NSWA + NCONV;
  for (;;) {
    __syncthreads();
    if (tidx() == 0) *ctl = (int)atomicAdd(p->counters + cidx, 1u);
    __syncthreads();
    const int it = *ctl;
    if (it >= TOTAL) break;
    if (it < NS5) s5_unit(p, l, it);
    else if (it < NS5 + NDIFF) diff_unit(p, l, it - NS5);
    else if (it < NS5 + NDIFF + NSWA) swa_unit(p, l, it - NS5 - NDIFF);
    else conv_unit(p, l, it - NS5 - NDIFF - NSWA);
  }
}
__device__ __forceinline__ void phase_cross_attn(KP p, int l) {
  for (int u = blockIdx.x; u < 512; u += gridDim.x) { __syncthreads(); cross_unit(p, l, u); }
}

__global__ void __launch_bounds__(512) fwd_megakernel(Params pv) {
  cg::grid_group grid = cg::this_grid();
  if (tidx() == 0) { const unsigned long long kp = (unsigned long long)__builtin_amdgcn_kernarg_segment_ptr();
    volatile __attribute__((address_space(3))) unsigned* s = (volatile __attribute__((address_space(3))) unsigned*)(smem + 136 * 1024 + 16);
    s[0] = (unsigned)kp; s[1] = (unsigned)(kp >> 32); s[4] = 0u; s[5] = 0u; }
  __syncthreads();
  if (tidx() == 0) (void)xb_add(&getp()->counters[XB_XCNT(xb_xcc_id())], 1u);
  phase_init(getp());
  grid.sync();
#pragma unroll 1
  for (int j = 0; j < 8; ++j) {
    const int l = j >> 1, second = j & 1;
    phase_ffn_a(getp(), second ? getp()->w1in : getp()->wbin, j == 0);
    gbar();
    phase_resid_ln(getp(), getp()->aq, FFN, second ? getp()->w1out : getp()->wbout, FFN, 0.5f, getp()->in[second ? 43 : 4] + l * 1024, getp()->in[second ? 44 : 5] + l * 1024, j == 7 ? getp()->out : (float*)nullptr, l * 4 + (second ? 3 : 0));
    if (!second) convert_mix(getp(), l);
    else if (l < 3) convert_ffn(getp(), getp()->in[2] + (long)(l + 1) * 1024 * 2 * FFN, getp()->in[3] + (long)(l + 1) * FFN * 1024, getp()->wbin, getp()->wbout);
    gbar();
    if (!second) {
      phase_mix_a(getp());
      gbar();
      phase_mixers(getp(), l, l);
      gbar();
      phase_s5_glu(getp(), l);
      gbar();
      phase_merge(getp());
      gbar();
      phase_resid_ln(getp(), getp()->cu, 1024, getp()->wout, 1024, 1.0f, getp()->in[32] + l * 1024, getp()->in[33] + l * 1024, (float*)nullptr, l * 4 + 1);
      convert_cross(getp(), l);
      gbar();
      phase_plain(getp()->x16, 1024, getp()->wq, 1024, getp()->aq, 512, 128, 2);
      gbar();
      phase_cross_attn(getp(), l);
      gbar();
      phase_resid_ln(getp(), getp()->dq, 512, getp()->wo, 512, 1.0f, getp()->in[39] + l * 1024, getp()->in[40] + l * 1024, (float*)nullptr, l * 4 + 2);
      convert_ffn(getp(), getp()->in[41] + (long)l * 1024 * 2 * FFN, getp()->in[42] + (long)l * FFN * 1024, getp()->w1in, getp()->w1out);
      gbar();
    }
  }
}

extern "C" void kernel_launch(void* const* d_in, const int* in_sizes, int n_in, void* d_out, int out_size, void* d_ws, size_t ws_size, hipStream_t stream) {
  Params p; memset(&p, 0, sizeof(p));
  for (int i = 0; i < 45; ++i) p.in[i] = (const float*)d_in[i];
  p.out = (float*)d_out;
  char* base = (char*)d_ws; size_t off = 0;
  auto carve = [&](size_t halves) { hf* r = (hf*)(base + off); off += (halves * 2 + 255) & ~(size_t)255; return r; };
  p.counters = (unsigned*)base; off = 32768;
  p.x16 = carve((size_t)NTOK * 1024);
  p.w1in = carve((size_t)5632 * 1024); p.w1out = carve((size_t)1024 * FFN);
  p.wbin = carve((size_t)5632 * 1024); p.wbout = carve((size_t)1024 * FFN);
  p.wmix = carve((size_t)7936 * 1024);
  p.pswa = carve(1024 * 512); p.ps5 = carve(1024 * 512); p.pconv = carve(1024 * 512); p.pdiff = carve(1024 * 512);
  p.glu = carve(512 * 512); p.wout = carve(1024 * 1024); p.wq = carve(512 * 1024); p.wo = carve(1024 * 512);
  p.wkv = carve((size_t)4 * 1024 * 1024); p.kvc = carve((size_t)4 * 4096 * 1024); p.memn = carve((size_t)4096 * 1024);
  p.aq = carve((size_t)NTOK * 512); p.akv = carve((size_t)NTOK * 256); p.dq = carve((size_t)NTOK * 512);
  p.dk = carve((size_t)NTOK * 512); p.dv = carve((size_t)NTOK * 512); p.su = carve((size_t)NTOK * 512); p.cu = carve((size_t)NTOK * 1024);
  p.s5tmp = carve((size_t)NTOK * 512); p.convout = carve((size_t)NTOK * 512);
  p.swo = carve((size_t)NTOK * 512); p.dfo = carve((size_t)NTOK * 512);
  p.xstat = (unsigned long long*)carve((size_t)NTOK * 4 * 4);
  static int grid_blocks = 0;
  if (!grid_blocks) {
    hipFuncSetAttribute((const void*)fwd_megakernel, hipFuncAttributeMaxDynamicSharedMemorySize, LDS_BYTES);
    int dev = 0, cus = 0, per_cu = 0;
    hipGetDevice(&dev);
    hipDeviceGetAttribute(&cus, hipDeviceAttributeMultiprocessorCount, dev);
    hipOccupancyMaxActiveBlocksPerMultiprocessor(&per_cu, fwd_megakernel, 512, LDS_BYTES);
    if (per_cu > 1) per_cu = 1;
    grid_blocks = cus * per_cu;
    if (grid_blocks <= 0) grid_blocks = 256;
  }
  (void)hipMemsetAsync(d_ws, 0, 32768, stream);
  void* args[] = {&p};
  hipError_t e = hipLaunchCooperativeKernel((const void*)fwd_megakernel, dim3(grid_blocks), dim3(512), args, LDS_BYTES, stream);
  if (e != hipSuccess) fprintf(stderr, "cooperative launch failed: %s (grid %d)\n", hipGetErrorString(e), grid_blocks);
}
```

```cpp
#include <hip/hip_runtime.h>
#include <hip/hip_cooperative_groups.h>
#include <cstdio>
#include <cstring>
namespace cg = cooperative_groups;

typedef _Float16 hf;
typedef _Float16 h8 __attribute__((ext_vector_type(8)));
typedef _Float16 h4 __attribute__((ext_vector_type(4)));
typedef short s4v __attribute__((ext_vector_type(4)));
typedef float f4 __attribute__((ext_vector_type(4)));

constexpr int NTOK = 32768, SEQ = 2048, FFN = 2816;
constexpr int LDS_BYTES = 140 * 1024;
constexpr int CTL_OFF = 136 * 1024;
constexpr float LOG2E = 1.4426950408889634f;
constexpr float DN_ALPHA = 1.681792830507429f;

struct Params {
  const float* in[45];
  float* out;
  hf *x16, *w1in, *w1out, *wbin, *wbout, *wmix, *pswa, *ps5, *pconv, *pdiff, *glu, *wout, *wq, *wo, *wkv, *kvc, *memn;
  hf *aq, *akv, *dq, *dk, *dv, *su, *cu, *s5tmp, *convout, *swo, *dfo;
  unsigned long long* xstat;
  unsigned* counters;
  unsigned pad_;
  unsigned pad2_;
};

extern __shared__ __attribute__((aligned(16))) unsigned char smem[];
__device__ __forceinline__ int tidx() { int t = __builtin_amdgcn_workitem_id_x(); asm volatile("" : "+v"(t)); return t; }
typedef const __attribute__((address_space(4))) Params* KP;
__device__ __forceinline__ KP getp() {
  volatile __attribute__((address_space(3))) unsigned* s = (volatile __attribute__((address_space(3))) unsigned*)(smem + 136 * 1024 + 16);
  const unsigned lo = __builtin_amdgcn_readfirstlane(s[0]), hi = __builtin_amdgcn_readfirstlane(s[1]);
  unsigned long long v = ((unsigned long long)hi << 32) | lo;
  asm volatile("" : "+s"(v));
  return (KP)v;
}

#define XB_TMO      128
#define XB_XCNT(j)  (256  + 64 * (j))
#define XB_XSUB(j)  (1280 + 64 * (j))
#define XB_XGEN(j)  (2304 + 64 * (j))
#define XB_TOP      3328
#define XB_TOPGEN   3392
#define XB_SPIN_CAP (1u << 20)
__device__ __forceinline__ unsigned xb_ld(unsigned* p)              { return __hip_atomic_load(p, __ATOMIC_RELAXED, __HIP_MEMORY_SCOPE_AGENT); }
__device__ __forceinline__ unsigned xb_add(unsigned* p, unsigned v) { return __hip_atomic_fetch_add(p, v, __ATOMIC_RELAXED, __HIP_MEMORY_SCOPE_AGENT); }
__device__ __forceinline__ unsigned xb_xcc_id() { return (unsigned)__builtin_amdgcn_s_getreg((3 << 11) | 20) & 0xFu; }
#define XB_SPIN(cond, bar) do { unsigned _sp = 0; while (cond) { __builtin_amdgcn_s_sleep(1); \
    if ((++_sp & 255u) == 0u) { if (xb_ld(&(bar)[XB_TMO])) break; if (_sp > XB_SPIN_CAP) { atomicAdd(&(bar)[XB_TMO], 1u); break; } } } } while (0)
__device__ __forceinline__ void xcd_barrier_complete(unsigned* bar, unsigned x, unsigned& nloc, unsigned& nx) {
  const unsigned G = gridDim.x;
  unsigned sum, cnt, mine, sp = 0u;
  for (;;) {
    sum = 0u; cnt = 0u; mine = 0u;
#pragma unroll
    for (unsigned j = 0; j < 16; ++j) { const unsigned c = xb_ld(&bar[XB_XCNT(j)]); sum += c; cnt += (c > 0u) ? 1u : 0u; mine = (j == x) ? c : mine; }
    if (sum == G) break;
    __builtin_amdgcn_s_sleep(1);
    if ((++sp & 255u) == 0u) { if (xb_ld(&bar[XB_TMO])) break; if (sp > XB_SPIN_CAP) { atomicAdd(&bar[XB_TMO], 1u); break; } }
  }
  nloc = mine > 0u ? mine : 1u; nx = cnt > 0u ? cnt : 1u;
}
__device__ __forceinline__ void gbar() {
  asm volatile("s_waitcnt vmcnt(0)" ::: "memory");
  __syncthreads();
  if (tidx() == 0) {
    unsigned* bar = getp()->counters;
    volatile __attribute__((address_space(3))) unsigned* st = (volatile __attribute__((address_space(3))) unsigned*)(smem + 136 * 1024 + 32);
    const unsigned x = xb_xcc_id();
    __builtin_amdgcn_s_waitcnt(0);
    unsigned nloc = st[0], nx = st[1];
    if (nloc == 0u) { xcd_barrier_complete(bar, x, nloc, nx); st[0] = nloc; st[1] = nx; }
    const unsigned old = xb_add(&bar[XB_XSUB(x)], 1u);
    const unsigned gen = old / nloc;
    if (old + 1u == (gen + 1u) * nloc) {
      __builtin_amdgcn_fence(__ATOMIC_RELEASE, "agent");
      asm volatile("s_waitcnt vmcnt(0)" ::: "memory");
      const unsigned og = xb_add(&bar[XB_TOP], 1u);
      const unsigned tg = og / nx;
      if (og + 1u == (tg + 1u) * nx) xb_add(&bar[XB_TOPGEN], 1u);
      else XB_SPIN(xb_ld(&bar[XB_TOPGEN]) == tg, bar);
      __builtin_amdgcn_fence(__ATOMIC_ACQUIRE, "agent");
      xb_add(&bar[XB_XGEN(x)], 1u);
      asm volatile("s_waitcnt vmcnt(0)" ::: "memory");
    } else {
      XB_SPIN(xb_ld(&bar[XB_XGEN(x)]) == gen, bar);
      __builtin_amdgcn_fence(__ATOMIC_ACQUIRE, "agent");
      asm volatile("s_waitcnt vmcnt(0)" ::: "memory");
    }
  }
  __syncthreads();
}

constexpr int BM = 256, BK = 64, HALFT = 128, HT = HALFT * BK;
__device__ __forceinline__ int lds_byte(int r, int c) {
  int st = (r >> 4) * 2 + (c >> 5), rr = r & 15, cc = c & 31, ob = rr * 64 + cc * 2;
  return st * 1024 + (ob ^ (((ob >> 9) & 1) << 5));
}
__device__ __forceinline__ void stage_rc(int b, int& R, int& C) {
  int st = b / 1024, sb = b % 1024, swz = sb ^ (((sb >> 9) & 1) << 5);
  R = (st >> 1) * 16 + swz / 64; C = (st & 1) * 32 + (swz % 64) / 2;
}
__device__ __forceinline__ bool tile_order(int i, int nM, int nN, int& pm, int& pn) {
  const int nwg = nM * nN; const int L = i * (int)gridDim.x + (int)blockIdx.x; if (L >= nwg) return false;
  int wgid = (int)L; { const int q = nwg / 8, r = nwg % 8, xcd = wgid % 8, off = wgid / 8; wgid = (xcd < r ? xcd * (q + 1) : r * (q + 1) + (xcd - r) * q) + off; }
  const int nig = 8 * nN, gid = wgid / nig, fm = gid * 8, gsz = (nM - fm) < 8 ? (nM - fm) : 8;
  pm = fm + ((wgid % nig) % gsz); pn = (wgid % nig) / gsz; return true;
}

#define LAS __attribute__((address_space(3)))
constexpr int HTB = HALFT * BK * 2;
struct GU { const char* A; const char* B; int lda, ldb, nt, brow, bcol, aux; };

template <class Prov, class Epi>
__device__ __forceinline__ void gemm_stream(Prov prov, Epi epi) {
  LAS unsigned char* lds = (LAS unsigned char*)smem;
  const int tid = tidx();
  const int wid = __builtin_amdgcn_readfirstlane(tid >> 6), lane = tid & 63, wr = wid >> 2, wc = wid & 3, fr = lane & 15, fq = lane >> 4;
  int sR[2], sC[2];
#pragma unroll
  for (int i = 0; i < 2; ++i) stage_rc(tid * 16 + i * 8192, sR[i], sC[i]);
  const size_t kstep = (size_t)(BK * 2);
  const unsigned ldsw = (unsigned)wid * 1024u;
  const int aoff = lds_byte(wr * 64 + fr, fq * 8), boff = lds_byte(wc * 32 + fr, fq * 8);
  GU cur, nxt;
  if (!prov(0, cur)) return;
  int ui = 0;
#define GSA(b, h) (((b)*2 + (h)) * HTB)
#define GSB(b, h) ((4 + (b)*2 + (h)) * HTB)
#define STAGE(bufoff, gbase, ld) do { _Pragma("unroll") for (int _i = 0; _i < 2; ++_i) \
    __builtin_amdgcn_global_load_lds((const unsigned*)((const char*)(gbase) + (unsigned)((sR[_i] * (ld) + sC[_i]) * 2)), (LAS unsigned*)(lds + (bufoff) + ldsw + _i * 8192), 16, 0, 0); } while (0)
#define LDA(dst, b, h) do { _Pragma("unroll") for (int m = 0; m < 4; ++m) _Pragma("unroll") for (int k = 0; k < 2; ++k) dst[m][k] = *(const LAS h8*)(lds + GSA(b, h) + aoff + m * 2048 + k * 1024); } while (0)
#define LDB(dst, b, h) do { _Pragma("unroll") for (int n = 0; n < 2; ++n) _Pragma("unroll") for (int k = 0; k < 2; ++k) dst[n][k] = *(const LAS h8*)(lds + GSB(b, h) + boff + n * 2048 + k * 1024); } while (0)
#define MMA(ai, bj, At_, Bt_) do { __builtin_amdgcn_s_setprio(1); _Pragma("unroll") for (int m = 0; m < 4; ++m) _Pragma("unroll") for (int n = 0; n < 2; ++n) _Pragma("unroll") for (int k = 0; k < 2; ++k) \
      acc[ai][bj][m][n] = __builtin_amdgcn_mfma_f32_16x16x32_f16(Bt_[n][k], At_[m][k], acc[ai][bj][m][n], 0, 0, 0); \
    __builtin_amdgcn_s_setprio(0); } while (0)
#define WAIT_V(n) asm volatile("s_waitcnt vmcnt(" #n ")" ::: "memory")
#define WAIT_L(n) asm volatile("s_waitcnt lgkmcnt(" #n ")" ::: "memory")
#define BAR __builtin_amdgcn_s_barrier()
#define SCHED __builtin_amdgcn_sched_barrier(0)
#define ZERO_ACC _Pragma("unroll") for (int a = 0; a < 2; ++a) _Pragma("unroll") for (int b = 0; b < 2; ++b) _Pragma("unroll") for (int m = 0; m < 4; ++m) _Pragma("unroll") for (int n = 0; n < 2; ++n) acc[a][b][m][n] = (f4){0.f, 0.f, 0.f, 0.f}
  f4 acc[2][2][4][2];
  ZERO_ACC;
  h8 At[4][2], B0[2][2], B1[2][2];
  { const size_t hA = (size_t)HALFT * cur.lda * 2, hB = (size_t)HALFT * cur.ldb * 2;
    STAGE(GSB(0, 0), cur.B, cur.ldb); STAGE(GSB(0, 1), cur.B + hB, cur.ldb); STAGE(GSA(0, 0), cur.A, cur.lda); STAGE(GSA(0, 1), cur.A + hA, cur.lda);
    if (wr == 1) BAR;
    WAIT_V(2); BAR;
    STAGE(GSB(1, 0), cur.B + kstep, cur.ldb); STAGE(GSA(1, 0), cur.A + kstep, cur.lda); STAGE(GSB(1, 1), cur.B + hB + kstep, cur.ldb);
    WAIT_V(6); BAR; }
#pragma unroll 1
  for (;;) {
    const bool has_next = prov(ui + 1, nxt);
    if (!has_next) nxt = cur;
    const int nt = cur.nt;
    const size_t hA = (size_t)HALFT * cur.lda * 2;
#pragma unroll 1
    for (int t = 0; t < nt; t += 2) {
      const bool last = (t + 2 >= nt);
      const char* a1 = cur.A + (size_t)(t + 1) * kstep + hA;
      const char* a2 = last ? nxt.A : cur.A + (size_t)(t + 2) * kstep;
      const char* b2 = last ? nxt.B : cur.B + (size_t)(t + 2) * kstep;
      const int lda2 = last ? nxt.lda : cur.lda, ldb2 = last ? nxt.ldb : cur.ldb;
      const size_t hA2 = (size_t)HALFT * lda2 * 2, hB2 = (size_t)HALFT * ldb2 * 2;
      LDB(B0, 0, 0); LDB(B1, 0, 1); SCHED; LDA(At, 0, 0); STAGE(GSA(1, 1), a1, cur.lda);
      WAIT_V(8); WAIT_L(0); BAR; MMA(0, 0, At, B0); MMA(0, 1, At, B1); BAR; SCHED;
      LDA(At, 0, 1); STAGE(GSB(0, 0), b2, ldb2); STAGE(GSB(0, 1), b2 + hB2, ldb2); STAGE(GSA(0, 0), a2, lda2);
      WAIT_V(8); WAIT_L(0); BAR; MMA(1, 0, At, B0); MMA(1, 1, At, B1); BAR; SCHED;
      LDB(B0, 1, 0); LDB(B1, 1, 1); SCHED; LDA(At, 1, 0); STAGE(GSA(0, 1), a2 + hA2, lda2);
      WAIT_V(8); WAIT_L(0); BAR; MMA(0, 0, At, B0); MMA(0, 1, At, B1); BAR; SCHED;
      LDA(At, 1, 1); STAGE(GSB(1, 0), b2 + kstep, ldb2); STAGE(GSB(1, 1), b2 + hB2 + kstep, ldb2); STAGE(GSA(1, 0), a2 + kstep, lda2);
      WAIT_V(8); WAIT_L(0); BAR; MMA(1, 0, At, B0); MMA(1, 1, At, B1); BAR; SCHED;
    }
    if (wr == 0) BAR;
    epi(acc, cur, wr, wc, fr, fq);
    ZERO_ACC;
    if (!has_next) break;
    cur = nxt; ++ui;
    if (wr == 1) BAR;
  }
  asm volatile("s_waitcnt vmcnt(0)" ::: "memory");
  __syncthreads();
#undef GSA
#undef GSB
#undef STAGE
#undef LDA
#undef LDB
#undef MMA
#undef ZERO_ACC
}

#define EPI_ARGS f4 (&acc)[2][2][4][2], const GU& d, int wr, int wc, int fr, int fq
#define EPI_ROWS _Pragma("unroll") for (int ai = 0; ai < 2; ++ai) _Pragma("unroll") for (int m = 0; m < 4; ++m)
#define EPI_COLS _Pragma("unroll") for (int bj = 0; bj < 2; ++bj) _Pragma("unroll") for (int n = 0; n < 2; ++n)
#define AINL __attribute__((always_inline))

__device__ __forceinline__ float sigmoidf_(float x) { return __builtin_amdgcn_rcpf(1.0f + __builtin_amdgcn_exp2f(-1.4426950408889634f * x)); }
__device__ __forceinline__ h4 cvt4(f4 v) { h4 r; r[0] = (hf)v[0]; r[1] = (hf)v[1]; r[2] = (hf)v[2]; r[3] = (hf)v[3]; return r; }
__device__ __forceinline__ h8 cvt8(f4 a, f4 b) { h8 r; r[0] = (hf)a[0]; r[1] = (hf)a[1]; r[2] = (hf)a[2]; r[3] = (hf)a[3]; r[4] = (hf)b[0]; r[5] = (hf)b[1]; r[6] = (hf)b[2]; r[7] = (hf)b[3]; return r; }
#define EPI_BJ _Pragma("unroll") for (int bj = 0; bj < 2; ++bj)
__device__ __forceinline__ void set_gu(GU& d, const hf* A, int lda, const hf* B, int ldb, int K, int brow, int bcol, int aux) {
  d.A = (const char*)(A + (size_t)brow * lda); d.B = (const char*)(B + (size_t)bcol * ldb); d.lda = lda; d.ldb = ldb; d.nt = K / BK; d.brow = brow; d.bcol = bcol; d.aux = aux;
}

__device__ __forceinline__ void phase_ffn_a(KP p, const hf* w_in, bool with_kv) {
  hf* hidden = p->aq; hf* kvc = p->kvc;
  const hf* x16 = p->x16; const hf* memn = p->memn; const hf* wkv = p->wkv;
  const int nA = 128 * 22, total = nA + (with_kv ? 256 : 0);
  gemm_stream([&](int i, GU& d) AINL -> bool {
      const int L = i * (int)gridDim.x + (int)blockIdx.x; if (L >= total) return false;
      if (L < nA) {
        int wgid = (int)L; const int q = nA / 8, off = wgid / 8, xcd = wgid % 8; wgid = xcd * q + off;
        const int nig = 8 * 22, gid = wgid / nig, fm = gid * 8, pm = fm + ((wgid % nig) % 8), pn = (wgid % nig) / 8;
        set_gu(d, x16, 1024, w_in, 1024, 1024, pm * 256, pn * 256, 0);
      } else {
        const int t = (int)L - nA, l = t >> 6, pm = (t & 63) >> 2, pn = t & 3;
        set_gu(d, memn, 1024, wkv + (size_t)l * 1024 * 1024, 1024, 1024, pm * 256, pn * 256, 1 + l);
      }
      return true; },
    [&](EPI_ARGS) AINL {
      if (d.aux == 0) {
        EPI_ROWS { const long row = d.brow + ai * 128 + wr * 64 + m * 16 + fr;
          f4 v[2];
          _Pragma("unroll") for (int n = 0; n < 2; ++n) { const f4 g = acc[ai][0][m][n], u = acc[ai][1][m][n];
            _Pragma("unroll") for (int j = 0; j < 4; ++j) v[n][j] = g[j] * sigmoidf_(g[j]) * u[j]; }
          *(h8*)(hidden + row * FFN + (d.bcol >> 1) + wc * 32 + fq * 8) = cvt8(v[0], v[1]); }
      } else {
        hf* dst = kvc + (size_t)(d.aux - 1) * 4096 * 1024;
        EPI_ROWS { const long row = d.brow + ai * 128 + wr * 64 + m * 16 + fr;
          EPI_BJ { *(h8*)(dst + row * 1024 + d.bcol + bj * 128 + wc * 32 + fq * 8) = cvt8(acc[ai][bj][m][0], acc[ai][bj][m][1]); } }
      } });
}

__device__ __forceinline__ void phase_resid(KP p, const hf* A, int lda, const hf* Wt, int K, float scale) {
  hf* y16 = p->s5tmp; const hf* res = p->x16;
  gemm_stream([&](int i, GU& d) AINL -> bool { int pm, pn; if (!tile_order(i, 128, 4, pm, pn)) return false; set_gu(d, A, lda, Wt, K, K, pm * 256, pn * 256, 0); return true; },
    [&](EPI_ARGS) AINL {
      EPI_ROWS { const long row = d.brow + ai * 128 + wr * 64 + m * 16 + fr;
        EPI_BJ { const long o = row * 1024 + d.bcol + bj * 128 + wc * 32 + fq * 8;
          const h8 r = *(const h8*)(res + o); f4 v0 = acc[ai][bj][m][0], v1 = acc[ai][bj][m][1];
          _Pragma("unroll") for (int j = 0; j < 4; ++j) { v0[j] = DN_ALPHA * (float)r[j] + scale * v0[j]; v1[j] = DN_ALPHA * (float)r[4 + j] + scale * v1[j]; }
          *(h8*)(y16 + o) = cvt8(v0, v1); } } });
}

__device__ __forceinline__ void phase_resid_ln(KP p, const hf* A, int lda, const hf* Wt, int K, float scale, const float* lng, const float* lnb, float* out32, int seq) {
  hf* x16 = p->x16; unsigned long long* xs = p->xstat; unsigned* pcnt = p->counters + 4096;
  gemm_stream([&](int i, GU& d) AINL -> bool { int pm, pn; if (!tile_order(i, 128, 4, pm, pn)) return false; set_gu(d, A, lda, Wt, K, K, pm * 256, pn * 256, pn); return true; },
    [&](EPI_ARGS) AINL {
      LAS float* P = (LAS float*)((LAS unsigned char*)smem + 131072);
      const int tid = tidx();
      h8 rres[2][4][2];
      EPI_ROWS { const long row = d.brow + ai * 128 + wr * 64 + m * 16 + fr;
        EPI_BJ { rres[ai][m][bj] = *(const h8*)(x16 + row * 1024 + d.bcol + bj * 128 + wc * 32 + fq * 8); } }
      EPI_ROWS { const int rl = ai * 128 + wr * 64 + m * 16 + fr; float s = 0.f, q = 0.f;
        EPI_BJ { const h8 r = rres[ai][m][bj];
          _Pragma("unroll") for (int j = 0; j < 4; ++j) { const float a0 = DN_ALPHA * (float)r[j] + scale * acc[ai][bj][m][0][j], a1 = DN_ALPHA * (float)r[4 + j] + scale * acc[ai][bj][m][1][j];
            acc[ai][bj][m][0][j] = a0; acc[ai][bj][m][1][j] = a1; s += a0 + a1; q += a0 * a0 + a1 * a1; } }
        s += __shfl_xor(s, 16); s += __shfl_xor(s, 32); q += __shfl_xor(q, 16); q += __shfl_xor(q, 32);
        if (fq == 0) { P[(rl * 4 + wc) * 2] = s; P[(rl * 4 + wc) * 2 + 1] = q; } }
      __syncthreads();
      if (tid < 256) { float s = 0.f, q = 0.f; _Pragma("unroll") for (int w4 = 0; w4 < 4; ++w4) { s += P[(tid * 4 + w4) * 2]; q += P[(tid * 4 + w4) * 2 + 1]; }
        const unsigned long long v = ((unsigned long long)__float_as_uint(q) << 32) | __float_as_uint(s);
        __hip_atomic_store(xs + (long)(d.brow + tid) * 4 + d.aux, v, __ATOMIC_RELAXED, __HIP_MEMORY_SCOPE_AGENT); }
      asm volatile("s_waitcnt vmcnt(0)" ::: "memory");
      __syncthreads();
      if (tid == 0) { unsigned* c = pcnt + (d.brow >> 8) * 16; __hip_atomic_fetch_add(c, 1u, __ATOMIC_RELAXED, __HIP_MEMORY_SCOPE_AGENT);
        const unsigned target = 4u * (unsigned)(seq + 1); unsigned sp = 0;
        while (__hip_atomic_load(c, __ATOMIC_RELAXED, __HIP_MEMORY_SCOPE_AGENT) < target) { __builtin_amdgcn_s_sleep(1); if (++sp > (1u << 22)) break; } }
      asm volatile("s_waitcnt vmcnt(0)" ::: "memory");
      __syncthreads();
      if (tid < 256) { float s = 0.f, q = 0.f;
        _Pragma("unroll") for (int pn = 0; pn < 4; ++pn) { const unsigned long long v = __hip_atomic_load(xs + (long)(d.brow + tid) * 4 + pn, __ATOMIC_RELAXED, __HIP_MEMORY_SCOPE_AGENT);
          s += __uint_as_float((unsigned)v); q += __uint_as_float((unsigned)(v >> 32)); }
        const float mu = s * (1.0f / 1024.0f), var = q * (1.0f / 1024.0f) - mu * mu;
        P[tid * 2] = mu; P[tid * 2 + 1] = rsqrtf(var + 1e-5f); }
      __syncthreads();
      EPI_ROWS { const int rl = ai * 128 + wr * 64 + m * 16 + fr; const long row = d.brow + rl; const float mu = P[rl * 2], rs = P[rl * 2 + 1];
        EPI_BJ { const int col = d.bcol + bj * 128 + wc * 32 + fq * 8; const long o = row * 1024 + col;
          const f4 g0 = *(const f4*)(lng + col), g1 = *(const f4*)(lng + col + 4), b0 = *(const f4*)(lnb + col), b1 = *(const f4*)(lnb + col + 4); f4 v0, v1;
          _Pragma("unroll") for (int j = 0; j < 4; ++j) { v0[j] = (acc[ai][bj][m][0][j] - mu) * rs * g0[j] + b0[j]; v1[j] = (acc[ai][bj][m][1][j] - mu) * rs * g1[j] + b1[j]; }
          *(h8*)(x16 + o) = cvt8(v0, v1);
          if (out32) { *(f4*)(out32 + o) = v0; *(f4*)(out32 + o + 4) = v1; } } }
      __syncthreads();
    });
}

__device__ __forceinline__ void phase_mix_a(KP p) {
  gemm_stream([&](int i, GU& d) AINL -> bool { int pm, pn; if (!tile_order(i, 128, 15, pm, pn)) return false; KP q = getp(); set_gu(d, q->x16, 1024, q->wmix, 1024, 1024, pm * 256, pn * 256, pn); return true; },
    [&](EPI_ARGS) AINL {
      const int pn = d.aux; hf* dst; int ldc, coff; KP q = getp();
      if (pn < 2) { dst = q->aq; ldc = 512; coff = pn * 256; }
      else if (pn == 2) { dst = q->akv; ldc = 256; coff = 0; }
      else if (pn < 5) { dst = q->dq; ldc = 512; coff = (pn - 3) * 256; }
      else if (pn < 7) { dst = q->dk; ldc = 512; coff = (pn - 5) * 256; }
      else if (pn < 9) { dst = q->dv; ldc = 512; coff = (pn - 7) * 256; }
      else if (pn < 11) { dst = q->su; ldc = 512; coff = (pn - 9) * 256; }
      else { dst = q->cu; ldc = 1024; coff = (pn - 11) * 256; }
      EPI_ROWS { const long row = d.brow + ai * 128 + wr * 64 + m * 16 + fr;
        EPI_BJ { *(h8*)(dst + row * ldc + coff + bj * 128 + wc * 32 + fq * 8) = cvt8(acc[ai][bj][m][0], acc[ai][bj][m][1]); } } });
}

__device__ __forceinline__ void phase_plain(const hf* A, int lda, const hf* Wt, int K, hf* dst, int ldc, int nM, int nN) {
  gemm_stream([&](int i, GU& d) AINL -> bool { int pm, pn; if (!tile_order(i, nM, nN, pm, pn)) return false; set_gu(d, A, lda, Wt, K, K, pm * 256, pn * 256, 0); return true; },
    [&](EPI_ARGS) AINL {
      EPI_ROWS { const long row = d.brow + ai * 128 + wr * 64 + m * 16 + fr;
        EPI_BJ { *(h8*)(dst + row * ldc + d.bcol + bj * 128 + wc * 32 + fq * 8) = cvt8(acc[ai][bj][m][0], acc[ai][bj][m][1]); } } });
}

__device__ __forceinline__ void phase_s5_glu(KP p, int l) {
  const float* gb = p->in[18] + l * 512; const hf* y = p->s5tmp; hf* dst = p->su; const hf* glu = p->glu;
  gemm_stream([&](int i, GU& d) AINL -> bool { int pm, pn; if (!tile_order(i, 128, 2, pm, pn)) return false; set_gu(d, y, 512, glu, 512, 512, pm * 256, pn * 256, 0); return true; },
    [&](EPI_ARGS) AINL {
      EPI_ROWS { const long row = d.brow + ai * 128 + wr * 64 + m * 16 + fr;
        EPI_BJ { const int col = d.bcol + bj * 128 + wc * 32 + fq * 8;
          const h8 yy = *(const h8*)(y + row * 512 + col); const f4 b0 = *(const f4*)(gb + col), b1 = *(const f4*)(gb + col + 4); f4 v0 = acc[ai][bj][m][0], v1 = acc[ai][bj][m][1];
          _Pragma("unroll") for (int j = 0; j < 4; ++j) { v0[j] = (float)yy[j] * sigmoidf_(v0[j] + b0[j]); v1[j] = (float)yy[4 + j] * sigmoidf_(v1[j] + b1[j]); }
          *(h8*)(dst + row * 512 + col) = cvt8(v0, v1); } } });
}

__device__ __forceinline__ void phase_merge(KP p) {
  gemm_stream([&](int idx, GU& d) AINL -> bool {
      const int it = idx >> 3, s = idx & 7, i = s >> 1; int pm, pn; if (!tile_order(it, 128, 4, pm, pn)) return false;
      KP q = getp();
      if ((s & 1) == 1) set_gu(d, q->x16, 1024, q->wmix + (size_t)(3840 + i * 1024) * 1024, 1024, 1024, pm * 256, pn * 256, s);
      else { const hf* A = i == 0 ? q->swo : i == 1 ? q->su : i == 2 ? q->convout : q->dfo; const hf* W = i == 0 ? q->pswa : i == 1 ? q->ps5 : i == 2 ? q->pconv : q->pdiff;
        set_gu(d, A, 512, W, 512, 512, pm * 256, pn * 256, s); }
      return true; },
    [&](EPI_ARGS) AINL {
      const int s = d.aux; KP q = getp(); hf* ybuf = q->dk; hf* merged = q->cu;
      if ((s & 1) == 0) {
        EPI_ROWS { const long row = d.brow + ai * 128 + wr * 64 + m * 16 + fr;
          EPI_BJ { *(h8*)(ybuf + row * 1024 + d.bcol + bj * 128 + wc * 32 + fq * 8) = cvt8(acc[ai][bj][m][0], acc[ai][bj][m][1]); } }
      } else {
        EPI_ROWS { const long row = d.brow + ai * 128 + wr * 64 + m * 16 + fr;
          EPI_BJ { const long o = row * 1024 + d.bcol + bj * 128 + wc * 32 + fq * 8;
            const h8 y = *(const h8*)(ybuf + o); h8 mo; if (s > 1) mo = *(const h8*)(merged + o);
            f4 v0 = acc[ai][bj][m][0], v1 = acc[ai][bj][m][1];
            _Pragma("unroll") for (int j = 0; j < 4; ++j) { v0[j] = sigmoidf_(v0[j]) * (float)y[j]; v1[j] = sigmoidf_(v1[j]) * (float)y[4 + j]; }
            if (s > 1) { _Pragma("unroll") for (int j = 0; j < 4; ++j) { v0[j] += (float)mo[j]; v1[j] += (float)mo[4 + j]; } }
            *(h8*)(merged + o) = cvt8(v0, v1); } }
      } });
}

__device__ __forceinline__ float wave_sum(float v) {
  for (int o = 32; o > 0; o >>= 1) v += __shfl_xor(v, o);
  return v;
}

__device__ __forceinline__ void ln_rows(const float* src, const float* g, const float* b, float* dst32, hf* dst16, int nrows) {
  const int wave = blockIdx.x * 8 + (tidx() >> 6), nw = gridDim.x * 8, lane = tidx() & 63;
  f4 gg[4], bb[4];
  for (int i = 0; i < 4; ++i) { gg[i] = *(const f4*)(g + i * 256 + lane * 4); bb[i] = *(const f4*)(b + i * 256 + lane * 4); }
  for (int r = wave; r < nrows; r += nw) {
    f4 v[4]; float s = 0.f;
    for (int i = 0; i < 4; ++i) { v[i] = *(const f4*)(src + (long)r * 1024 + i * 256 + lane * 4); s += (v[i][0] + v[i][1]) + (v[i][2] + v[i][3]); }
    const float mu = wave_sum(s) * (1.0f / 1024.0f);
    float q = 0.f;
    for (int i = 0; i < 4; ++i) for (int j = 0; j < 4; ++j) { const float d = v[i][j] - mu; q += d * d; }
    const float rs = rsqrtf(wave_sum(q) * (1.0f / 1024.0f) + 1e-5f);
    for (int i = 0; i < 4; ++i) { f4 o; for (int j = 0; j < 4; ++j) o[j] = (v[i][j] - mu) * rs * gg[i][j] + bb[i][j];
      if (dst32) *(f4*)(dst32 + (long)r * 1024 + i * 256 + lane * 4) = o;
      *(h4*)(dst16 + (long)r * 1024 + i * 256 + lane * 4) = cvt4(o); }
  }
}

__device__ __forceinline__ void ln_rows16(const hf* src, const float* g, const float* b, float* dst32, hf* dst16, int nrows) {
  const int wave = blockIdx.x * 8 + (tidx() >> 6), nw = gridDim.x * 8, lane = tidx() & 63;
  f4 gg[4], bb[4];
  for (int i = 0; i < 4; ++i) { gg[i] = *(const f4*)(g + i * 256 + lane * 4); bb[i] = *(const f4*)(b + i * 256 + lane * 4); }
  for (int r = wave; r < nrows; r += nw) {
    f4 v[4]; float s = 0.f;
    for (int i = 0; i < 4; ++i) { const h4 t = *(const h4*)(src + (long)r * 1024 + i * 256 + lane * 4); v[i][0] = (float)t[0]; v[i][1] = (float)t[1]; v[i][2] = (float)t[2]; v[i][3] = (float)t[3];
      s += (v[i][0] + v[i][1]) + (v[i][2] + v[i][3]); }
    const float mu = wave_sum(s) * (1.0f / 1024.0f);
    float q = 0.f;
    for (int i = 0; i < 4; ++i) for (int j = 0; j < 4; ++j) { const float d = v[i][j] - mu; q += d * d; }
    const float rs = rsqrtf(wave_sum(q) * (1.0f / 1024.0f) + 1e-5f);
    for (int i = 0; i < 4; ++i) { f4 o; for (int j = 0; j < 4; ++j) o[j] = (v[i][j] - mu) * rs * gg[i][j] + bb[i][j];
      if (dst32) *(f4*)(dst32 + (long)r * 1024 + i * 256 + lane * 4) = o;
      *(h4*)(dst16 + (long)r * 1024 + i * 256 + lane * 4) = cvt4(o); }
  }
}

__device__ __forceinline__ void conv_w_job(const float* __restrict__ src, int ld, int K, hf* __restrict__ dst, int NBk  , int mode, int coloff) {
  float* tile = (float*)smem;
  const int nkb = K / 64, total = NBk * nkb, tid = tidx();
  for (int u = blockIdx.x; u < total; u += gridDim.x) {
    const int nb = u / nkb, kb = u % nkb;
    int c0;
    if (mode == 0) c0 = coloff + nb * 64;
    else { const int j = nb >> 2, sub = nb & 3; c0 = (sub < 2) ? (j * 128 + sub * 64) : (FFN + j * 128 + (sub - 2) * 64); }
    __syncthreads();
    for (int h = 0; h < 2; ++h) { const int kk = (tid >> 4) + h * 32, c4 = tid & 15;
      const f4 v = *(const f4*)(src + (long)(kb * 64 + kk) * ld + c0 + c4 * 4);
      for (int j = 0; j < 4; ++j) tile[kk * 65 + c4 * 4 + j] = v[j]; }
    __syncthreads();
    { const int n = tid >> 3, k8 = tid & 7; h8 o;
      const int rho = n & 31, ii = rho & 15, ns = (n & 32) + 8 * (ii >> 2) + 4 * (rho >> 4) + (ii & 3);
      for (int j = 0; j < 8; ++j) o[j] = (hf)tile[(k8 * 8 + j) * 65 + ns];
      *(h8*)(dst + (long)(nb * 64 + n) * K + kb * 64 + k8 * 8) = o; }
  }
}

__device__ __forceinline__ void convert_ffn(KP p, const float* w_in, const float* w_out, hf* din, hf* dout) {
  conv_w_job(w_in, 2 * FFN, 1024, din, 88, 1, 0);
  conv_w_job(w_out, 1024, FFN, dout, 16, 0, 0);
}
__device__ __forceinline__ void convert_mix(KP p, int l) {
  conv_w_job(p->in[6] + (long)l * 1024 * 7936, 7936, 1024, p->wmix, 124, 0, 0);
  conv_w_job(p->in[8] + (long)l * 512 * 1024, 1024, 512, p->pswa, 16, 0, 0);
  conv_w_job(p->in[19] + (long)l * 512 * 1024, 1024, 512, p->ps5, 16, 0, 0);
  conv_w_job(p->in[24] + (long)l * 512 * 1024, 1024, 512, p->pconv, 16, 0, 0);
  conv_w_job(p->in[30] + (long)l * 512 * 1024, 1024, 512, p->pdiff, 16, 0, 0);
  conv_w_job(p->in[17] + (long)l * 512 * 512, 512, 512, p->glu, 8, 0, 0);
  conv_w_job(p->in[31] + (long)l * 1024 * 1024, 1024, 1024, p->wout, 16, 0, 0);
}
__device__ __forceinline__ void convert_cross(KP p, int l) {
  conv_w_job(p->in[36] + (long)l * 1024 * 512, 512, 1024, p->wq, 8, 0, 0);
  conv_w_job(p->in[38] + (long)l * 512 * 1024, 1024, 512, p->wo, 16, 0, 0);
}

__device__ __forceinline__ void phase_init(KP p) {
  { const long n4 = (long)NTOK * 1024 / 4; const f4* s = (const f4*)p->in[0]; h4* d = (h4*)p->x16;
    for (long i = (long)blockIdx.x * 512 + tidx(); i < n4; i += (long)gridDim.x * 512) d[i] = cvt4(s[i]); }
  ln_rows(p->in[1], p->in[34], p->in[35], nullptr, p->memn, 4096);
  convert_ffn(p, p->in[2], p->in[3], p->wbin, p->wbout);
  for (int l = 0; l < 4; ++l) conv_w_job(p->in[37] + (long)l * 1024 * 1024, 1024, 1024, p->wkv + (long)l * 1024 * 1024, 16, 0, 0);
}

__device__ __forceinline__ h4 trrd(const hf* q) { return __builtin_bit_cast(h4, __builtin_amdgcn_ds_read_tr16_b64_v4i16((__attribute__((address_space(3))) s4v*)q)); }

template <int DK, int DV, int KW, bool ALIBI, int MASK>
__device__ __forceinline__ void attn_core(const hf* __restrict__ Kg, long kstride, const hf* __restrict__ Vg, long vstride, int T0, int T1,
                                          const hf* __restrict__ Qw, long qstride, int kcol, int q0, float c1, float c2,
                                          f4 (&O)[2][DV / 16], float (&m)[2], float (&l)[2]) {
  constexpr int KSTR = KW + 8, VSTR = DV + 8, KCH = KW / 8, VCH = DV / 8, NKL = 64 * KCH / 512, NVL = 64 * VCH / 512;
  hf* Ks = (hf*)smem; hf* Vs = Ks + 64 * KSTR;
  const int tid = tidx(), lane = tid & 63, fr = lane & 15, fq = lane >> 4;
  h8 qf[2][DK / 32];
#pragma unroll
  for (int qs = 0; qs < 2; ++qs)
#pragma unroll
    for (int ks = 0; ks < DK / 32; ++ks) qf[qs][ks] = *(const h8*)(Qw + (long)(qs * 16 + fr) * qstride + ks * 32 + fq * 8);
  h8 kreg[NKL], vreg[NVL];
#pragma unroll
  for (int i = 0; i < NKL; ++i) { const int idx = tid + i * 512, r = idx / KCH, c = idx % KCH; kreg[i] = *(const h8*)(Kg + (long)(T0 * 64 + r) * kstride + c * 8); }
#pragma unroll
  for (int i = 0; i < NVL; ++i) { const int idx = tid + i * 512, r = idx / VCH, c = idx % VCH; vreg[i] = *(const h8*)(Vg + (long)(T0 * 64 + r) * vstride + c * 8); }
#pragma unroll 1
  for (int T = T0; T < T1; ++T) {
    __syncthreads();
#pragma unroll
    for (int i = 0; i < NKL; ++i) { const int idx = tid + i * 512, r = idx / KCH, c = idx % KCH; *(h8*)(Ks + r * KSTR + c * 8) = kreg[i]; }
#pragma unroll
    for (int i = 0; i < NVL; ++i) { const int idx = tid + i * 512, r = idx / VCH, c = idx % VCH; *(h8*)(Vs + r * VSTR + c * 8) = vreg[i]; }
    __syncthreads();
    if (T + 1 < T1) {
#pragma unroll
      for (int i = 0; i < NKL; ++i) { const int idx = tid + i * 512, r = idx / KCH, c = idx % KCH; kreg[i] = *(const h8*)(Kg + (long)((T + 1) * 64 + r) * kstride + c * 8); }
#pragma unroll
      for (int i = 0; i < NVL; ++i) { const int idx = tid + i * 512, r = idx / VCH, c = idx % VCH; vreg[i] = *(const h8*)(Vg + (long)((T + 1) * 64 + r) * vstride + c * 8); }
    }
    bool rel = true;
    if (MASK >= 1) rel = (T * 64 <= q0 + 31);
    if (MASK == 2) rel = rel && (T * 64 + 63 >= q0 - 127);
    if (rel) {
      f4 S[2][4];
#pragma unroll
      for (int kt = 0; kt < 4; ++kt) {
#pragma unroll
        for (int qs = 0; qs < 2; ++qs) S[qs][kt] = (f4){0.f, 0.f, 0.f, 0.f};
#pragma unroll
        for (int ks = 0; ks < DK / 32; ++ks) {
          const h8 kf = *(const h8*)(Ks + (kt * 16 + fr) * KSTR + kcol + ks * 32 + fq * 8);
#pragma unroll
          for (int qs = 0; qs < 2; ++qs) S[qs][kt] = __builtin_amdgcn_mfma_f32_16x16x32_f16(kf, qf[qs][ks], S[qs][kt], 0, 0, 0);
        }
      }
      h8 pf[2][2];
#pragma unroll
      for (int qs = 0; qs < 2; ++qs) {
        const int qp = q0 + qs * 16 + fr;
        float mx = m[qs];
        const float abase = ALIBI ? c2 * (float)(T * 64 + fq * 4 - qp) : 0.f;
        const bool need_mask = (MASK == 2) || (MASK == 1 && (T * 64 + 63 > q0));
        if (need_mask) {
#pragma unroll
          for (int kt = 0; kt < 4; ++kt)
#pragma unroll
            for (int jj = 0; jj < 4; ++jj) {
              const int kp = T * 64 + kt * 16 + fq * 4 + jj;
              float s = fmaf(S[qs][kt][jj], c1, ALIBI ? fmaf(c2, (float)(kt * 16 + jj), abase) : 0.f);
              if (MASK == 1) s = (kp <= qp) ? s : -1e30f;
              if (MASK == 2) s = (kp <= qp && qp - kp < 128) ? s : -1e30f;
              S[qs][kt][jj] = s; mx = fmaxf(mx, s);
            }
        } else {
#pragma unroll
          for (int kt = 0; kt < 4; ++kt)
#pragma unroll
            for (int jj = 0; jj < 4; ++jj) {
              const float s = fmaf(S[qs][kt][jj], c1, ALIBI ? fmaf(c2, (float)(kt * 16 + jj), abase) : 0.f);
              S[qs][kt][jj] = s; mx = fmaxf(mx, s);
            }
        }
        mx = fmaxf(mx, __shfl_xor(mx, 16)); mx = fmaxf(mx, __shfl_xor(mx, 32));
        const float alpha = __builtin_amdgcn_exp2f(m[qs] - mx); m[qs] = mx;
        float ps = 0.f;
#pragma unroll
        for (int kt = 0; kt < 4; ++kt)
#pragma unroll
          for (int jj = 0; jj < 4; ++jj) { const float pv = __builtin_amdgcn_exp2f(S[qs][kt][jj] - mx); ps += pv; S[qs][kt][jj] = pv; }
        l[qs] = l[qs] * alpha + ps;
#pragma unroll
        for (int et = 0; et < DV / 16; ++et) O[qs][et] *= alpha;
#pragma unroll
        for (int pr = 0; pr < 2; ++pr)
#pragma unroll
          for (int jj = 0; jj < 4; ++jj) { pf[qs][pr][jj] = (hf)S[qs][2 * pr][jj]; pf[qs][pr][4 + jj] = (hf)S[qs][2 * pr + 1][jj]; }
      }
#pragma unroll
      for (int pr = 0; pr < 2; ++pr)
#pragma unroll
        for (int et = 0; et < DV / 16; ++et) {
          const h4 v0 = trrd(Vs + (pr * 32 + fq * 4 + (fr >> 2)) * VSTR + et * 16 + (fr & 3) * 4);
          const h4 v1 = trrd(Vs + (pr * 32 + 16 + fq * 4 + (fr >> 2)) * VSTR + et * 16 + (fr & 3) * 4);
          h8 vf; vf[0] = v0[0]; vf[1] = v0[1]; vf[2] = v0[2]; vf[3] = v0[3]; vf[4] = v1[0]; vf[5] = v1[1]; vf[6] = v1[2]; vf[7] = v1[3];
#pragma unroll
          for (int qs = 0; qs < 2; ++qs) O[qs][et] = __builtin_amdgcn_mfma_f32_16x16x32_f16(vf, pf[qs][pr], O[qs][et], 0, 0, 0);
        }
    }
  }
}

__device__ __forceinline__ void swa_unit(KP p, int l, int u) {
  const int hp = u & 1, n = (u >> 1) & 15, g = (u >> 5) & 1, b = u >> 6;
  const int w = tidx() >> 6, lane = tidx() & 63, fr = lane & 15, fq = lane >> 4;
  const int hq = g * 4 + hp * 2 + (w >> 2), q0 = n * 128 + (w & 3) * 32;
  const hf* Kg = p->akv + (long)b * SEQ * 256 + g * 64; const hf* Vg = Kg + 128;
  hf* Qw = p->aq + ((long)b * SEQ + q0) * 512 + hq * 64;
  hf* Ow = p->swo + ((long)b * SEQ + q0) * 512 + hq * 64;
  const float slope = exp2f(-(float)(hq + 1));
  f4 O[2][4]; float m[2], ls[2];
  const float sink = p->in[7][l * 8 + hq] * LOG2E;
  for (int qs = 0; qs < 2; ++qs) { m[qs] = sink; ls[qs] = (fq == 0) ? 1.f : 0.f; for (int et = 0; et < 4; ++et) O[qs][et] = (f4){0.f, 0.f, 0.f, 0.f}; }
  const int T0 = (2 * n - 2) < 0 ? 0 : (2 * n - 2), T1 = 2 * n + 2;
  attn_core<64, 64, 64, true, 2>(Kg, 256, Vg, 256, T0, T1, Qw, 512, 0, q0, 0.125f * LOG2E, slope * LOG2E, O, m, ls);
  for (int qs = 0; qs < 2; ++qs) {
    float lt = ls[qs]; lt += __shfl_xor(lt, 16); lt += __shfl_xor(lt, 32);
    const float inv = 1.0f / lt;
    for (int et = 0; et < 4; ++et) *(h4*)(Ow + (long)(qs * 16 + fr) * 512 + et * 16 + fq * 4) = cvt4(O[qs][et] * inv);
  }
}

__device__ __forceinline__ void diff_unit(KP p, int l, int u) {
  const int n = 15 - (u >> 6), h = u & 3, b = (u >> 2) & 15;
  const int w = tidx() >> 6, lane = tidx() & 63, fr = lane & 15, fq = lane >> 4;
  const int comp = w & 1, q0 = n * 128 + (w >> 1) * 32;
  const hf* Kg = p->dk + (long)b * SEQ * 512 + h * 128; const hf* Vg = p->dv + (long)b * SEQ * 512 + h * 128;
  hf* Qrow = p->dq + ((long)b * SEQ + q0) * 512 + h * 128;
  hf* Orow = p->dfo + ((long)b * SEQ + q0) * 512 + h * 128;
  const float slope = exp2f(-2.0f * (float)(h + 1));
  const float lambda_init = 0.8f - 0.6f * expf(-0.3f * (float)l);
  float lam;
  { const float a = p->in[25][l * 64 + lane] * p->in[26][l * 64 + lane], c = p->in[27][l * 64 + lane] * p->in[28][l * 64 + lane];
    lam = expf(wave_sum(a)) - expf(wave_sum(c)) + lambda_init; }
  f4 O[2][8]; float m[2], ls[2];
  for (int qs = 0; qs < 2; ++qs) { m[qs] = -1e30f; ls[qs] = 0.f; for (int et = 0; et < 8; ++et) O[qs][et] = (f4){0.f, 0.f, 0.f, 0.f}; }
  attn_core<64, 128, 128, true, 1>(Kg, 512, Vg, 512, 0, 2 * n + 2, Qrow + comp * 64, 512, comp * 64, q0, 0.125f * LOG2E, slope * LOG2E, O, m, ls);
  float inv[2];
  for (int qs = 0; qs < 2; ++qs) { float lt = ls[qs]; lt += __shfl_xor(lt, 16); lt += __shfl_xor(lt, 32); inv[qs] = 1.0f / lt; }
  __syncthreads();
  float* XS = (float*)smem + (w >> 1) * 4096;
  if (comp == 1) {
    for (int qs = 0; qs < 2; ++qs) for (int et = 0; et < 8; ++et) for (int jj = 0; jj < 4; ++jj) XS[((qs * 8 + et) * 4 + jj) * 64 + lane] = O[qs][et][jj] * inv[qs];
  }
  __syncthreads();
  if (comp == 0) {
    const float* ng = p->in[29] + l * 128;
    for (int qs = 0; qs < 2; ++qs) {
      float ss = 0.f;
      for (int et = 0; et < 8; ++et) for (int jj = 0; jj < 4; ++jj) { const float v = O[qs][et][jj] * inv[qs] - lam * XS[((qs * 8 + et) * 4 + jj) * 64 + lane]; O[qs][et][jj] = v; ss += v * v; }
      ss += __shfl_xor(ss, 16); ss += __shfl_xor(ss, 32);
      const float r = rsqrtf(ss * (1.0f / 128.0f) + 1e-5f) * (1.0f - lambda_init);
      for (int et = 0; et < 8; ++et) { const f4 g4 = *(const f4*)(ng + et * 16 + fq * 4); f4 v = O[qs][et];
        for (int jj = 0; jj < 4; ++jj) v[jj] = v[jj] * r * g4[jj];
        *(h4*)(Orow + (long)(qs * 16 + fr) * 512 + et * 16 + fq * 4) = cvt4(v); }
    }
  }
}

__device__ __forceinline__ void cross_unit(KP p, int l, int u) {
  const int qb = u & 7, h = (u >> 3) & 3, b = u >> 5;
  const int w = tidx() >> 6, lane = tidx() & 63, fr = lane & 15, fq = lane >> 4;
  const int q0 = qb * 256 + w * 32;
  const hf* Kg = p->kvc + (long)l * 4096 * 1024 + (long)b * 256 * 1024 + h * 128; const hf* Vg = Kg + 512;
  const hf* Qw = p->aq + ((long)b * SEQ + q0) * 512 + h * 128;
  hf* Ow = p->dq + ((long)b * SEQ + q0) * 512 + h * 128;
  f4 O[2][8]; float m[2], ls[2];
  for (int qs = 0; qs < 2; ++qs) { m[qs] = -1e30f; ls[qs] = 0.f; for (int et = 0; et < 8; ++et) O[qs][et] = (f4){0.f, 0.f, 0.f, 0.f}; }
  attn_core<128, 128, 128, false, 0>(Kg, 1024, Vg, 1024, 0, 4, Qw, 512, 0, q0, 0.08838834764831845f * LOG2E, 0.f, O, m, ls);
  for (int qs = 0; qs < 2; ++qs) {
    float lt = ls[qs]; lt += __shfl_xor(lt, 16); lt += __shfl_xor(lt, 32);
    const float inv = 1.0f / lt;
    for (int et = 0; et < 8; ++et) *(h4*)(Ow + (long)(qs * 16 + fr) * 512 + et * 16 + fq * 4) = cvt4(O[qs][et] * inv);
  }
}

__device__ __forceinline__ void s5_unit(KP p, int l, int u) {
  const int b = u >> 2, w = tidx() >> 6, g = (u & 3) * 8 + w, lane = tidx() & 63, fr = lane & 15, fq = lane >> 4;
  float* BuS = (float*)(smem + w * 12800);
  float* Yt = BuS + 16 * 132;
  const int lg = l * 32 + g;
  const float step = expf(p->in[11][lg]);
  float abr, abi;
  { const float ar = p->in[9][lg * 64 + lane], ai = p->in[10][lg * 64 + lane]; const float mag = expf(ar * step); abr = mag * cosf(ai * step); abi = mag * sinf(ai * step); }
  h8 bfr[8];
#pragma unroll
  for (int nt = 0; nt < 8; ++nt) {
    const int pp = (nt & 3) * 16 + fr;
    const float ar = p->in[9][lg * 64 + pp], ai = p->in[10][lg * 64 + pp]; const float mag = expf(ar * step);
    const float nr = mag * cosf(ai * step) - 1.0f, ni = mag * sinf(ai * step), den = ar * ar + ai * ai;
    const float cr = (nr * ar + ni * ai) / den, ci = (ni * ar - nr * ai) / den;
    const float* brp = p->in[12] + ((long)lg * 64 + pp) * 16 + (fq & 1) * 8; const float* bip = p->in[13] + ((long)lg * 64 + pp) * 16 + (fq & 1) * 8;
#pragma unroll
    for (int s = 0; s < 8; ++s) { const float v = (nt < 4) ? (cr * brp[s] - ci * bip[s]) : (cr * bip[s] + ci * brp[s]); bfr[nt][s] = (fq < 2) ? (hf)v : (hf)0.0f; }
  }
  h8 cfr[4];
#pragma unroll
  for (int ks = 0; ks < 4; ++ks) {
    const float* src = (ks < 2 ? p->in[14] : p->in[15]) + ((long)lg * 16 + fr) * 64 + (ks & 1) * 32 + fq * 8;
    const float sg = ks < 2 ? 1.0f : -1.0f;
#pragma unroll
    for (int j = 0; j < 8; ++j) cfr[ks][j] = (hf)(sg * src[j]);
  }
  h8 dfr;
  { const float dd = p->in[16][l * 512 + g * 16 + fr];
#pragma unroll
    for (int s = 0; s < 8; ++s) dfr[s] = (fq < 2 && (fq & 1) * 8 + s == fr) ? (hf)dd : (hf)0.0f; }
  float xr = 0.f, xi = 0.f;
  const hf* up = p->su + (long)b * SEQ * 512 + g * 16 + (fq & 1) * 8;
  hf* yp = p->s5tmp + (long)b * SEQ * 512 + g * 16;
  h8 un = *(const h8*)(up + (long)fr * 512);
#pragma unroll 1
  for (int ch = 0; ch < 128; ++ch) {
    h8 uf = un;
    if (fq >= 2) { for (int s = 0; s < 8; ++s) uf[s] = (hf)0.0f; }
    if (ch < 127) un = *(const h8*)(up + (long)((ch + 1) * 16 + fr) * 512);
#pragma unroll
    for (int nt = 0; nt < 8; ++nt) {
      const f4 d = __builtin_amdgcn_mfma_f32_16x16x32_f16(uf, bfr[nt], (f4){0.f, 0.f, 0.f, 0.f}, 0, 0, 0);
#pragma unroll
      for (int jj = 0; jj < 4; ++jj) BuS[(fq * 4 + jj) * 132 + nt * 16 + fr] = d[jj];
    }
    __syncthreads();
    float br_[16], bi_[16];
#pragma unroll
    for (int t = 0; t < 16; ++t) { br_[t] = BuS[t * 132 + lane]; bi_[t] = BuS[t * 132 + 64 + lane]; }
#pragma unroll
    for (int t = 0; t < 16; ++t) {
      const float nxr = abr * xr - abi * xi + br_[t], nxi = abr * xi + abi * xr + bi_[t]; xr = nxr; xi = nxi;
      BuS[t * 132 + lane] = xr; BuS[t * 132 + 64 + lane] = xi;
    }
    __syncthreads();
    f4 y = (f4){0.f, 0.f, 0.f, 0.f};
#pragma unroll
    for (int ks = 0; ks < 4; ++ks) {
      const f4 xa = *(const f4*)(BuS + fr * 132 + ks * 32 + fq * 8), xb = *(const f4*)(BuS + fr * 132 + ks * 32 + fq * 8 + 4);
      h8 xf; xf[0] = (hf)xa[0]; xf[1] = (hf)xa[1]; xf[2] = (hf)xa[2]; xf[3] = (hf)xa[3]; xf[4] = (hf)xb[0]; xf[5] = (hf)xb[1]; xf[6] = (hf)xb[2]; xf[7] = (hf)xb[3];
      y = __builtin_amdgcn_mfma_f32_16x16x32_f16(xf, cfr[ks], y, 0, 0, 0);
    }
    y = __builtin_amdgcn_mfma_f32_16x16x32_f16(uf, dfr, y, 0, 0, 0);
#pragma unroll
    for (int jj = 0; jj < 4; ++jj) {
      const float v = y[jj], z = 0.7978845608028654f * (v + 0.044715f * v * v * v);
      const float th = 1.0f - 2.0f * __builtin_amdgcn_rcpf(__builtin_amdgcn_exp2f(2.8853900817779268f * z) + 1.0f);
      Yt[(fq * 4 + jj) * 20 + fr] = 0.5f * v * (1.0f + th);
    }
    __syncthreads();
    { const int t = lane >> 2, c4 = (lane & 3) * 4; const f4 v = *(const f4*)(Yt + t * 20 + c4);
      *(h4*)(yp + (long)(ch * 16 + t) * 512 + c4) = cvt4(v); }
  }
}

__device__ __forceinline__ void conv_unit(KP p, int l, int u) {
  const int b = u >> 5, t0 = (u & 31) * 64, tid = tidx(), w = tid >> 6, lane = tid & 63;
  hf* G = (hf*)smem;
  hf* Wc = (hf*)(smem + 96256);
  for (int idx = tid; idx < 94 * 64; idx += 512) {
    const int r = idx >> 6, c8 = idx & 63, t = t0 - 30 + r; h8 o;
    if (t >= 0) { const hf* src = p->cu + ((long)b * SEQ + t) * 1024 + c8 * 8; const h8 v = *(const h8*)src, gt = *(const h8*)(src + 512);
      for (int j = 0; j < 8; ++j) o[j] = (hf)((float)v[j] * sigmoidf_((float)gt[j])); }
    else { for (int j = 0; j < 8; ++j) o[j] = (hf)0.0f; }
    *(h8*)(G + r * 512 + c8 * 8) = o;
  }
  { const float* cw = p->in[20] + (long)l * 31 * 512; for (int idx = tid; idx < 31 * 512; idx += 512) Wc[idx] = (hf)cw[idx]; }
  __syncthreads();
  const float* cb = p->in[21] + l * 512 + lane * 8; const f4 b0 = *(const f4*)cb, b1 = *(const f4*)(cb + 4);
  const float* lg = p->in[22] + l * 512 + lane * 8; const float* lb = p->in[23] + l * 512 + lane * 8;
  const f4 g0 = *(const f4*)lg, g1 = *(const f4*)(lg + 4), c0 = *(const f4*)lb, c1 = *(const f4*)(lb + 4);
#pragma unroll 1
  for (int jp = 0; jp < 4; ++jp) {
    float a0[8], a1[8];
#pragma unroll
    for (int c = 0; c < 8; ++c) { a0[c] = c < 4 ? b0[c & 3] : b1[c & 3]; a1[c] = a0[c]; }
    const hf* gp = G + (w * 8 + jp * 2) * 512 + lane * 8;
    h8 wprev;
#pragma unroll
    for (int c = 0; c < 8; ++c) wprev[c] = (hf)0.0f;
#pragma unroll 8
    for (int k = 0; k < 32; ++k) {
      const h8 gv = *(const h8*)(gp + k * 512);
      h8 wv;
      if (k < 31) wv = *(const h8*)(Wc + k * 512 + lane * 8); else { for (int c = 0; c < 8; ++c) wv[c] = (hf)0.0f; }
#pragma unroll
      for (int c = 0; c < 8; ++c) { a0[c] += (float)gv[c] * (float)wv[c]; a1[c] += (float)gv[c] * (float)wprev[c]; }
      wprev = wv;
    }
#pragma unroll
    for (int jj = 0; jj < 2; ++jj) {
      float s = 0.f;
#pragma unroll
      for (int c = 0; c < 8; ++c) s += jj ? a1[c] : a0[c];
      const float mu = wave_sum(s) * (1.0f / 512.0f);
      float q = 0.f;
#pragma unroll
      for (int c = 0; c < 8; ++c) { const float d = (jj ? a1[c] : a0[c]) - mu; q += d * d; }
      const float rs = rsqrtf(wave_sum(q) * (1.0f / 512.0f) + 1e-5f);
      h8 o;
#pragma unroll
      for (int c = 0; c < 8; ++c) { const float gg = c < 4 ? g0[c & 3] : g1[c & 3], bb = c < 4 ? c0[c & 3] : c1[c & 3];
        const float v = ((jj ? a1[c] : a0[c]) - mu) * rs * gg + bb; o[c] = (hf)(v * sigmoidf_(v)); }
      *(h8*)(p->convout + ((long)b * SEQ + t0 + w * 8 + jp * 2 + jj) * 512 + lane * 8) = o;
    }
  }
}

__device__ __forceinline__ void phase_mixers(KP p, int l, int cidx) {
  volatile int* ctl = (volatile int*)(smem + CTL_OFF);
  const int NS5 = 64, NDIFF = 1024, NSWA = 1024, NCONV = 512, TOTAL = NS5 + NDIFF + NSWA + NCONV;
  for (;;) {
    __syncthreads();
    if (tidx() == 0) *ctl = (int)atomicAdd(p->counters + cidx, 1u);
    __syncthreads();
    const int it = *ctl;
    if (it >= TOTAL) break;
    if (it < NS5) s5_unit(p, l, it);
    else if (it < NS5 + NDIFF) diff_unit(p, l, it - NS5);
    else if (it < NS5 + NDIFF + NSWA) swa_unit(p, l, it - NS5 - NDIFF);
    else conv_unit(p, l, it - NS5 - NDIFF - NSWA);
  }
}
__device__ __forceinline__ void phase_cross_attn(KP p, int l) {
  for (int u = blockIdx.x; u < 512; u += gridDim.x) { __syncthreads(); cross_unit(p, l, u); }
}

__global__ void __launch_bounds__(512) fwd_megakernel(Params pv) {
  cg::grid_group grid = cg::this_grid();
  if (tidx() == 0) { const unsigned long long kp = (unsigned long long)__builtin_amdgcn_kernarg_segment_ptr();
    volatile __attribute__((address_space(3))) unsigned* s = (volatile __attribute__((address_space(3))) unsigned*)(smem + 136 * 1024 + 16);
    s[0] = (unsigned)kp; s[1] = (unsigned)(kp >> 32); s[4] = 0u; s[5] = 0u; }
  __syncthreads();
  if (tidx() == 0) (void)xb_add(&getp()->counters[XB_XCNT(xb_xcc_id())], 1u);
  phase_init(getp());
  grid.sync();
#pragma unroll 1
  for (int j = 0; j < 8; ++j) {
    const int l = j >> 1, second = j & 1;
    phase_ffn_a(getp(), second ? getp()->w1in : getp()->wbin, j == 0);
    gbar();
    phase_resid_ln(getp(), getp()->aq, FFN, second ? getp()->w1out : getp()->wbout, FFN, 0.5f, getp()->in[second ? 43 : 4] + l * 1024, getp()->in[second ? 44 : 5] + l * 1024, j == 7 ? getp()->out : (float*)nullptr, l * 4 + (second ? 3 : 0));
    if (!second) convert_mix(getp(), l);
    else if (l < 3) convert_ffn(getp(), getp()->in[2] + (long)(l + 1) * 1024 * 2 * FFN, getp()->in[3] + (long)(l + 1) * FFN * 1024, getp()->wbin, getp()->wbout);
    gbar();
    if (!second) {
      phase_mix_a(getp());
      gbar();
      phase_mixers(getp(), l, l);
      gbar();
      phase_s5_glu(getp(), l);
      gbar();
      phase_merge(getp());
      gbar();
      phase_resid_ln(getp(), getp()->cu, 1024, getp()->wout, 1024, 1.0f, getp()->in[32] + l * 1024, getp()->in[33] + l * 1024, (float*)nullptr, l * 4 + 1);
      convert_cross(getp(), l);
      gbar();
      phase_plain(getp()->x16, 1024, getp()->wq, 1024, getp()->aq, 512, 128, 2);
      gbar();
      phase_cross_attn(getp(), l);
      gbar();
      phase_resid_ln(getp(), getp()->dq, 512, getp()->wo, 512, 1.0f, getp()->in[39] + l * 1024, getp()->in[40] + l * 1024, (float*)nullptr, l * 4 + 2);
      convert_ffn(getp(), getp()->in[41] + (long)l * 1024 * 2 * FFN, getp()->in[42] + (long)l * FFN * 1024, getp()->w1in, getp()->w1out);
      gbar();
    }
  }
}

extern "C" void kernel_launch(void* const* d_in, const int* in_sizes, int n_in, void* d_out, int out_size, void* d_ws, size_t ws_size, hipStream_t stream) {
  Params p; memset(&p, 0, sizeof(p));
  for (int i = 0; i < 45; ++i) p.in[i] = (const float*)d_in[i];
  p.out = (float*)d_out;
  char* base = (char*)d_ws; size_t off = 0;
  auto carve = [&](size_t halves) { hf* r = (hf*)(base + off); off += (halves * 2 + 255) & ~(size_t)255; return r; };
  p.counters = (unsigned*)base; off = 32768;
  p.x16 = carve((size_t)NTOK * 1024);
  p.w1in = carve((size_t)5632 * 1024); p.w1out = carve((size_t)1024 * FFN);
  p.wbin = carve((size_t)5632 * 1024); p.wbout = carve((size_t)1024 * FFN);
  p.wmix = carve((size_t)7936 * 1024);
  p.pswa = carve(1024 * 512); p.ps5 = carve(1024 * 512); p.pconv = carve(1024 * 512); p.pdiff = carve(1024 * 512);
  p.glu = carve(512 * 512); p.wout = carve(1024 * 1024); p.wq = carve(512 * 1024); p.wo = carve(1024 * 512);
  p.wkv = carve((size_t)4 * 1024 * 1024); p.kvc = carve((size_t)4 * 4096 * 1024); p.memn = carve((size_t)4096 * 1024);
  p.aq = carve((size_t)NTOK * 512); p.akv = carve((size_t)NTOK * 256); p.dq = carve((size_t)NTOK * 512);
  p.dk = carve((size_t)NTOK * 512); p.dv = carve((size_t)NTOK * 512); p.su = carve((size_t)NTOK * 512); p.cu = carve((size_t)NTOK * 1024);
  p.s5tmp = carve((size_t)NTOK * 512); p.convout = carve((size_t)NTOK * 512);
  p.swo = carve((size_t)NTOK * 512); p.dfo = carve((size_t)NTOK * 512);
  p.xstat = (unsigned long long*)carve((size_t)NTOK * 4 * 4);
  static int grid_blocks = 0;
  if (!grid_blocks) {
    hipFuncSetAttribute((const void*)fwd_megakernel, hipFuncAttributeMaxDynamicSharedMemorySize, LDS_BYTES);
    int dev = 0, cus = 0, per_cu = 0;
    hipGetDevice(&dev);
    hipDeviceGetAttribute(&cus, hipDeviceAttributeMultiprocessorCount, dev);
    hipOccupancyMaxActiveBlocksPerMultiprocessor(&per_cu, fwd_megakernel, 512, LDS_BYTES);
    if (per_cu > 1) per_cu = 1;
    grid_blocks = cus * per_cu;
    if (grid_blocks <= 0) grid_blocks = 256;
  }
  (void)hipMemsetAsync(d_ws, 0, 32768, stream);
  void* args[] = {&p};
  hipError_t e = hipLaunchCooperativeKernel((const void*)fwd_megakernel, dim3(grid_blocks), dim3(512), args, LDS_BYTES, stream);
  if (e != hipSuccess) fprintf(stderr, "cooperative launch failed: %s (grid %d)\n", hipGetErrorString(e), grid_blocks);
}
```
